# Optimizing an MI355X kernel written in HIP

```python
import jax, jax.numpy as jnp
from jax import lax
import numpy as np

D_MODEL = 2048
BATCH = 16
SEQ = 2048
DEPTH = 1

CHUNK = 64
N_META = 16
LEAD_PAD = CHUNK - N_META
Q_BLOCK = 128

MIX_WIDTH = D_MODEL
RET_WIDTH = MIX_WIDTH // 2
MLA_WIDTH = MIX_WIDTH - RET_WIDTH

RET_HEADS = 8
RET_HEAD_DIM = RET_WIDTH // RET_HEADS

MLA_HEADS = 8
MLA_V_DIM = MLA_WIDTH // MLA_HEADS
MLA_NOPE_DIM = 128
MLA_ROPE_DIM = 64
Q_LORA = 512
KV_LORA = 256
MLA_QK_DIM = MLA_NOPE_DIM + MLA_ROPE_DIM

D_FF = 4 * D_MODEL

ROPE_BASE = 10000.0
EPS = 1e-6

IN_SIZES = [RET_WIDTH, RET_WIDTH, RET_WIDTH, RET_WIDTH, Q_LORA, KV_LORA, MLA_ROPE_DIM]
IN_WIDTH = int(sum(IN_SIZES))
IN_SPLITS = [int(v) for v in np.cumsum(IN_SIZES)[:-1]]

kernel_name = "hymba_retention_mla_streaming_block"


def rmsnorm(x, g):
    xf = x.astype(jnp.float32)
    y = xf * lax.rsqrt(jnp.mean(xf * xf, axis=-1, keepdims=True) + EPS)
    return (y * g.astype(jnp.float32)).astype(x.dtype)


def rope_tables(pos, dim):
    inv = 1.0 / (ROPE_BASE ** (jnp.arange(0, dim, 2, dtype=jnp.float32) / dim))
    ang = pos[:, None] * inv[None, :]
    return jnp.cos(ang), jnp.sin(ang)


def apply_rope(x, cos, sin):
    half = x.shape[-1] // 2
    cos = cos.astype(x.dtype)
    sin = sin.astype(x.dtype)
    x1, x2 = x[..., :half], x[..., half:]
    return jnp.concatenate([x1 * cos - x2 * sin, x1 * sin + x2 * cos], axis=-1)


def retention_chunkwise(q, k, v):
    B, L, H, dk = q.shape
    dv = v.shape[-1]
    nc = L // CHUNK
    dt = q.dtype
    log_gamma = jnp.log(1.0 - 2.0 ** (-5.0 - jnp.arange(H, dtype=jnp.float32)))
    q = (q * (dk ** -0.5)).reshape(B, nc, CHUNK, H, dk)
    k = k.reshape(B, nc, CHUNK, H, dk)
    v = v.reshape(B, nc, CHUNK, H, dv)
    idx = jnp.arange(CHUNK, dtype=jnp.float32)
    dist = jnp.abs(idx[:, None] - idx[None, :])
    d_intra = jnp.exp(log_gamma[:, None, None] * dist[None]).astype(dt)
    scores = jnp.einsum('bnihd,bnjhd->bnhij', q, k) * d_intra
    o_intra = jnp.einsum('bnhij,bnjhe->bnihe', scores, v)
    w_k = jnp.exp(log_gamma[None, :] * (CHUNK - 1.0 - idx)[:, None]).astype(dt)
    kv = jnp.einsum('bnjhd,jh,bnjhe->bnhde', k, w_k, v)
    chunk_decay = jnp.exp(log_gamma * CHUNK).astype(kv.dtype)[None, :, None, None]

    def step(state, kv_c):
        return state * chunk_decay + kv_c, state

    _, states = lax.scan(step, jnp.zeros((B, H, dk, dv), kv.dtype), jnp.moveaxis(kv, 1, 0))
    states = jnp.moveaxis(states, 0, 1)
    w_q = jnp.exp(log_gamma[None, :] * (idx + 1.0)[:, None]).astype(dt)
    o_inter = jnp.einsum('bnihd,ih,bnhde->bnihe', q, w_q, states)
    return (o_intra + o_inter).reshape(B, L, H, dv)


def head_groupnorm(o, g):
    of = o.astype(jnp.float32)
    mu = jnp.mean(of, axis=-1, keepdims=True)
    var = jnp.mean(jnp.square(of - mu), axis=-1, keepdims=True)
    y = ((of - mu) * lax.rsqrt(var + EPS)).reshape(o.shape[0], o.shape[1], -1)
    return (y * g.astype(jnp.float32)).astype(o.dtype)


def mla_attention(q_lat, q_rope, c_kv, k_rope, chunk_id, key_valid):
    B, L, H, C = q_lat.shape
    nqb = L // Q_BLOCK
    scale = MLA_QK_DIM ** -0.5
    neg = jnp.finfo(jnp.float32).min
    ql_b = jnp.moveaxis(q_lat.reshape(B, nqb, Q_BLOCK, H, C), 1, 0)
    qr_b = jnp.moveaxis(q_rope.reshape(B, nqb, Q_BLOCK, H, q_rope.shape[-1]), 1, 0)
    qc_b = chunk_id.reshape(nqb, Q_BLOCK)

    def attend(args):
        ql, qr, qc = args
        s = (jnp.einsum('bqhc,bkc->bhqk', ql, c_kv)
             + jnp.einsum('bqhr,bkr->bhqk', qr, k_rope)).astype(jnp.float32) * scale
        mask = (chunk_id[None, :] <= qc[:, None]) & key_valid[None, :]
        s = jnp.where(mask[None, None], s, neg)
        p = jax.nn.softmax(s, axis=-1).astype(c_kv.dtype)
        return jnp.einsum('bhqk,bkc->bqhc', p, c_kv)

    o = lax.map(attend, (ql_b, qr_b, qc_b))
    return jnp.moveaxis(o, 0, 1).reshape(B, L, H, C)


def setup_inputs(seed: int = 0) -> dict:
    key = jax.random.key(seed)
    ks = jax.random.split(key, 16)
    f32 = jnp.float32

    def w(k, shape, fan_in):
        return jax.random.normal(k, shape, f32) * (fan_in ** -0.5)

    def gain(k, shape):
        return 1.0 + 0.02 * jax.random.normal(k, shape, f32)

    return {
        "x": jax.random.normal(ks[0], (BATCH, SEQ, D_MODEL), f32),
        "meta_tokens": jax.random.normal(ks[1], (N_META, D_MODEL), f32),
        "norm_mix_g": gain(ks[2], (DEPTH, D_MODEL)),
        "w_in": w(ks[3], (DEPTH, D_MODEL, IN_WIDTH), D_MODEL),
        "ret_out_g": gain(ks[4], (DEPTH, RET_WIDTH)),
        "q_norm_g": gain(ks[5], (DEPTH, Q_LORA)),
        "w_uq": w(ks[6], (DEPTH, Q_LORA, MLA_HEADS * MLA_QK_DIM), Q_LORA),
        "kv_norm_g": gain(ks[7], (DEPTH, KV_LORA)),
        "w_uk": w(ks[8], (DEPTH, KV_LORA, MLA_HEADS * MLA_NOPE_DIM), KV_LORA),
        "w_uv": w(ks[9], (DEPTH, KV_LORA, MLA_HEADS * MLA_V_DIM), KV_LORA),
        "mla_out_g": gain(ks[10], (DEPTH, MLA_WIDTH)),
        "w_o": w(ks[11], (DEPTH, MIX_WIDTH, D_MODEL), MIX_WIDTH),
        "norm_mlp_g": gain(ks[12], (DEPTH, D_MODEL)),
        "w_up": w(ks[13], (DEPTH, D_MODEL, D_FF), D_MODEL),
        "w_down": w(ks[14], (DEPTH, D_FF, D_MODEL), D_FF),
        "final_norm_g": gain(ks[15], (D_MODEL,)),
    }


def reference(x, meta_tokens, norm_mix_g, w_in, ret_out_g, q_norm_g, w_uq, kv_norm_g,
              w_uk, w_uv, mla_out_g, w_o, norm_mlp_g, w_up, w_down, final_norm_g):
    B, S, D = x.shape
    dt = x.dtype
    tail = (-(CHUNK + S)) % Q_BLOCK
    L = CHUNK + S + tail
    h = jnp.concatenate([
        jnp.zeros((B, LEAD_PAD, D), dt),
        jnp.broadcast_to(meta_tokens.astype(dt)[None], (B, N_META, D)),
        x,
        jnp.zeros((B, tail, D), dt),
    ], axis=1)

    p = jnp.arange(L)
    chunk_id = p // CHUNK
    key_valid = p >= LEAD_PAD
    valid_f = key_valid.astype(dt)[None, :, None, None]
    pos = jnp.maximum(p - LEAD_PAD, 0).astype(jnp.float32)
    cos_r, sin_r = rope_tables(pos, RET_HEAD_DIM)
    cos_m, sin_m = rope_tables(pos, MLA_ROPE_DIM)

    for l in range(DEPTH):
        u = rmsnorm(h, norm_mix_g[l])
        proj = u @ w_in[l]
        rq, rk, rv, rg, cq, ckv, kr = jnp.split(proj, IN_SPLITS, axis=-1)

        rq = apply_rope(rq.reshape(B, L, RET_HEADS, RET_HEAD_DIM), cos_r[:, None, :], sin_r[:, None, :])
        rk = apply_rope(rk.reshape(B, L, RET_HEADS, RET_HEAD_DIM), cos_r[:, None, :], sin_r[:, None, :]) * valid_f
        rv = rv.reshape(B, L, RET_HEADS, RET_HEAD_DIM)
        ret = retention_chunkwise(rq, rk, rv)
        ret_out = jax.nn.silu(rg) * head_groupnorm(ret, ret_out_g[l])

        c_q = rmsnorm(cq, q_norm_g[l])
        q = (c_q @ w_uq[l]).reshape(B, L, MLA_HEADS, MLA_QK_DIM)
        q_nope = q[..., :MLA_NOPE_DIM]
        q_rope = apply_rope(q[..., MLA_NOPE_DIM:], cos_m[:, None, :], sin_m[:, None, :])
        c_kv = rmsnorm(ckv, kv_norm_g[l])
        k_rope = apply_rope(kr, cos_m, sin_m)
        w_uk_h = w_uk[l].reshape(KV_LORA, MLA_HEADS, MLA_NOPE_DIM)
        w_uv_h = w_uv[l].reshape(KV_LORA, MLA_HEADS, MLA_V_DIM)
        q_lat = jnp.einsum('blhd,chd->blhc', q_nope, w_uk_h)
        o_lat = mla_attention(q_lat, q_rope, c_kv, k_rope, chunk_id, key_valid)
        mla = jnp.einsum('blhc,chv->blhv', o_lat, w_uv_h).reshape(B, L, MLA_WIDTH)
        mla_out = rmsnorm(mla, mla_out_g[l])

        h = h + jnp.concatenate([ret_out, mla_out], axis=-1) @ w_o[l]

        m = rmsnorm(h, norm_mlp_g[l])
        h = h + jnp.square(jax.nn.relu(m @ w_up[l])) @ w_down[l]

    return rmsnorm(h[:, CHUNK:CHUNK + S], final_norm_g)
```

```cpp
#include <hip/hip_runtime.h>
#include <hip/hip_cooperative_groups.h>
#include <cstdio>
#include <cstdint>
namespace cg = cooperative_groups;
#ifndef ONE_LAUNCH
#define ONE_LAUNCH 1
#endif
#ifndef NAIVE_RET
#define NAIVE_RET 0
#endif
#ifndef NAIVE_MLA
#define NAIVE_MLA 0
#endif
typedef unsigned long long u64;
namespace pg8 {
#define PG8_LAS __attribute__((address_space(3)))
typedef unsigned short bf16_t;
typedef short bf16x8 __attribute__((ext_vector_type(8)));
typedef float f32x4 __attribute__((ext_vector_type(4)));
typedef unsigned u32x4 __attribute__((ext_vector_type(4)));
constexpr int BM = 256, BK = 64, HALF = 128, HTB = HALF * BK * 2  , STAGE_BYTES = 8 * HTB, NXCD = 8, WGM = 8;

__host__ __device__ __forceinline__ int lds_byte(int r, int c) { const int st = (r >> 4) * 2 + (c >> 5), rr = r & 15, cc = c & 31, ob = rr * 64 + cc * 2; return st * 1024 + (ob ^ (((ob >> 9) & 1) << 5)); }
__host__ __device__ __forceinline__ void stage_rc(int b, int& R, int& C) { const int st = b / 1024, sb = b % 1024, swz = sb ^ (((sb >> 9) & 1) << 5); R = (st >> 1) * 16 + swz / 64; C = (st & 1) * 32 + (swz % 64) / 2; }
__host__ __device__ __forceinline__ int perm32(int rho) { const int n = rho >> 4, i = rho & 15; return 8 * (i >> 2) + 4 * n + (i & 3); }

struct Unit { int pm, pn; };
struct Gemm { const bf16_t* A; const bf16_t* Bt; int M, N, K; };

struct StaticOrder {
    int nM, nN, nwg, G, c;
    __host__ __device__ void init(int M, int N, int G_, int c_) { nM = M / BM; nN = N / BM; nwg = nM * nN; G = G_; c = c_; }
    __host__ __device__ bool next(int i, Unit& u) const {
        const long L = (long)i * G + c; if (L >= nwg) return false;
        int wgid = (int)L; { const int q = nwg / NXCD, r = nwg % NXCD, xcd = wgid % NXCD, off = wgid / NXCD; wgid = (xcd < r ? xcd * (q + 1) : r * (q + 1) + (xcd - r) * q) + off; }
        const int nig = WGM * nN, gid = wgid / nig, fm = gid * WGM, gsz = (nM - fm) < WGM ? (nM - fm) : WGM;
        u.pm = fm + ((wgid % nig) % gsz); u.pn = (wgid % nig) / gsz; return true;
    }
    __device__ __forceinline__ void a_ready(const Unit&) const {}
    __device__ __forceinline__ void done(const Unit&) const {}
};

__device__ __forceinline__ unsigned cvt_pk_bf16(float lo, float hi) { unsigned r; asm volatile("v_cvt_pk_bf16_f32 %0, %1, %2" : "=v"(r) : "v"(lo), "v"(hi)); return r; }
typedef unsigned u32x2 __attribute__((ext_vector_type(2)));
constexpr float FIXS = 16777216.0f;
__device__ __forceinline__ float sq4(const f32x4 v) { return (v[0] * v[0] + v[1] * v[1]) + (v[2] * v[2] + v[3] * v[3]); }
__device__ __forceinline__ u32x4 pack8(const f32x4 v0, const f32x4 v1) { u32x4 w; w.x = cvt_pk_bf16(v0[0], v0[1]); w.y = cvt_pk_bf16(v0[2], v0[3]); w.z = cvt_pk_bf16(v1[0], v1[1]); w.w = cvt_pk_bf16(v1[2], v1[3]); return w; }

struct EpiInProj {
    static constexpr bool PERM = true, AFTER_DRAIN = false, MIDK = false;
    bf16_t *RQ, *RK, *RV, *RG, *CQ, *CKV, *KR; u64 *SSQ, *SSKV;
    __device__ __forceinline__ void midk(f32x4 (&)[2][2][4][2], const Unit&, int, int) const {}
    __device__ __forceinline__ void operator()(const f32x4 (&acc)[2][2][4][2], const Unit& u, int wr, int wc, int fr, int fq) const {
        const int pn = u.pn, b = u.pm >> 3;
        bf16_t* base; int ld, c0; bool padded; u64* ss = nullptr;
        if (pn < 4)        { base = RQ;  ld = 1024; c0 = 256 * pn;        padded = false; }
        else if (pn < 8)   { base = RK;  ld = 1024; c0 = 256 * (pn - 4);  padded = true; }
        else if (pn < 12)  { base = RV;  ld = 1024; c0 = 256 * (pn - 8);  padded = true; }
        else if (pn < 16)  { base = RG;  ld = 1024; c0 = 256 * (pn - 12); padded = false; }
        else if (pn < 18)  { base = CQ;  ld = 512;  c0 = 256 * (pn - 16); padded = false; ss = SSQ; }
        else if (pn == 18) { base = CKV; ld = 256;  c0 = 0;               padded = true;  ss = SSKV; }
        else               { base = KR;  ld = 64;   c0 = 0;               padded = true; }
        const int row0 = u.pm * BM + wr * 64 + fr + (padded ? 64 * (b + 1) : 0);
        const int ct = wc * 32 + 8 * fq;
        const bool full = pn < 19;
#pragma unroll
        for (int ai = 0; ai < 2; ++ai)
#pragma unroll
            for (int m = 0; m < 4; ++m) {
                const int r = row0 + ai * HALF + m * 16;
                bf16_t* rowp = base + (size_t)r * ld + c0 + ct;
                float s = 0.f;
#pragma unroll
                for (int bj = 0; bj < 2; ++bj) {
                    const f32x4 v0 = acc[ai][bj][m][0], v1 = acc[ai][bj][m][1];
                    s += sq4(v0) + sq4(v1);
                    if (full || (bj == 0 && wc < 2)) *(u32x4*)(rowp + bj * HALF) = pack8(v0, v1);
                }
                if (ss) { s += __shfl_xor(s, 16); s += __shfl_xor(s, 32); if (fq == 0) atomicAdd(ss + r, (u64)(s * FIXS)); }
            }
    }
};
struct EpiRowScale {
    static constexpr bool PERM = true, AFTER_DRAIN = false, MIDK = false;
    bf16_t* O; int ld; const u64* ss; float inv;
    __device__ __forceinline__ void midk(f32x4 (&)[2][2][4][2], const Unit&, int, int) const {}
    __device__ __forceinline__ void operator()(const f32x4 (&acc)[2][2][4][2], const Unit& u, int wr, int wc, int fr, int fq) const {
        const int row0 = u.pm * BM + wr * 64 + fr, col0 = u.pn * BM + wc * 32 + 8 * fq;
#pragma unroll
        for (int ai = 0; ai < 2; ++ai)
#pragma unroll
            for (int m = 0; m < 4; ++m) {
                const int r = row0 + ai * HALF + m * 16;
                const float sc = rsqrtf((float)ss[r] * inv + 1e-6f);
                bf16_t* rowp = O + (size_t)r * ld + col0;
#pragma unroll
                for (int bj = 0; bj < 2; ++bj) *(u32x4*)(rowp + bj * HALF) = pack8(acc[ai][bj][m][0] * sc, acc[ai][bj][m][1] * sc);
            }
    }
};
struct EpiColScale {
    static constexpr bool PERM = true, AFTER_DRAIN = false, MIDK = false;
    bf16_t* O; int ld; const u64* ss; float inv;
    __device__ __forceinline__ void midk(f32x4 (&)[2][2][4][2], const Unit&, int, int) const {}
    __device__ __forceinline__ void operator()(const f32x4 (&acc)[2][2][4][2], const Unit& u, int wr, int wc, int fr, int fq) const {
        const int row0 = u.pm * BM + wr * 64 + fr, col0 = u.pn * BM + wc * 32 + 8 * fq;
        f32x4 sc[2][2];
#pragma unroll
        for (int bj = 0; bj < 2; ++bj)
#pragma unroll
            for (int n = 0; n < 2; ++n)
#pragma unroll
                for (int j = 0; j < 4; ++j) sc[bj][n][j] = rsqrtf((float)ss[col0 + bj * HALF + 4 * n + j] * inv + 1e-6f);
#pragma unroll
        for (int ai = 0; ai < 2; ++ai)
#pragma unroll
            for (int m = 0; m < 4; ++m) {
                const int r = row0 + ai * HALF + m * 16;
                bf16_t* rowp = O + (size_t)r * ld + col0;
#pragma unroll
                for (int bj = 0; bj < 2; ++bj) *(u32x4*)(rowp + bj * HALF) = pack8(acc[ai][bj][m][0] * sc[bj][0], acc[ai][bj][m][1] * sc[bj][1]);
            }
    }
};
struct EpiWo {
    static constexpr bool PERM = false, AFTER_DRAIN = false, MIDK = true;
    const float* x; float* out; bf16_t* xn2; u64* ssh1; const u64* ssmla;
    __device__ __forceinline__ void midk(f32x4 (&acc)[2][2][4][2], const Unit& u, int wr, int fr) const {
#pragma unroll
        for (int ai = 0; ai < 2; ++ai)
#pragma unroll
            for (int m = 0; m < 4; ++m) {
                const int r = u.pm * BM + ai * HALF + wr * 64 + m * 16 + fr;
                const float sc = rsqrtf((float)ssmla[r] * (1.0f / (FIXS * 1024.0f)) + 1e-6f);
#pragma unroll
                for (int bj = 0; bj < 2; ++bj)
#pragma unroll
                    for (int n = 0; n < 2; ++n) acc[ai][bj][m][n] = acc[ai][bj][m][n] * sc;
            }
    }
    __device__ __forceinline__ void operator()(const f32x4 (&acc)[2][2][4][2], const Unit& u, int wr, int wc, int fr, int fq) const {
        const int col0 = u.pn * BM + wc * 32 + 4 * fq;
#pragma unroll
        for (int ai = 0; ai < 2; ++ai)
#pragma unroll
            for (int m = 0; m < 4; ++m) {
                const int r = u.pm * BM + ai * HALF + wr * 64 + m * 16 + fr; const size_t off = (size_t)r * 2048 + col0;
                float s = 0.f;
#pragma unroll
                for (int bj = 0; bj < 2; ++bj)
#pragma unroll
                    for (int n = 0; n < 2; ++n) {
                        const f32x4 h = *(const f32x4*)(x + off + bj * HALF + n * 16) + acc[ai][bj][m][n];
                        u32x2 w; w.x = cvt_pk_bf16(h[0], h[1]); w.y = cvt_pk_bf16(h[2], h[3]);
                        *(u32x2*)(xn2 + off + bj * HALF + n * 16) = w;
                        s += sq4(h);
                    }
                s += __shfl_xor(s, 16); s += __shfl_xor(s, 32);
                if (fq == 0) atomicAdd(ssh1 + r, (u64)(s * FIXS));
            }
    }
};
struct EpiUp {
    static constexpr bool PERM = true, AFTER_DRAIN = false, MIDK = false;
    bf16_t* O; const u64* ss;
    __device__ __forceinline__ void midk(f32x4 (&)[2][2][4][2], const Unit&, int, int) const {}
    __device__ __forceinline__ void operator()(const f32x4 (&acc)[2][2][4][2], const Unit& u, int wr, int wc, int fr, int fq) const {
        const int row0 = u.pm * BM + wr * 64 + fr, col0 = u.pn * BM + wc * 32 + 8 * fq;
#pragma unroll
        for (int ai = 0; ai < 2; ++ai)
#pragma unroll
            for (int m = 0; m < 4; ++m) {
                const int r = row0 + ai * HALF + m * 16;
                const float sc = rsqrtf((float)ss[r] * (1.0f / (FIXS * 2048.0f)) + 1e-6f);
                bf16_t* rowp = O + (size_t)r * 8192 + col0;
#pragma unroll
                for (int bj = 0; bj < 2; ++bj) {
                    f32x4 v0 = acc[ai][bj][m][0] * sc, v1 = acc[ai][bj][m][1] * sc;
#pragma unroll
                    for (int j = 0; j < 4; ++j) { const float a = fmaxf(v0[j], 0.f), c = fmaxf(v1[j], 0.f); v0[j] = a * a; v1[j] = c * c; }
                    *(u32x4*)(rowp + bj * HALF) = pack8(v0, v1);
                }
            }
    }
};
struct PanelOrder {
    int G, v;
    __device__ __forceinline__ bool next(int i, Unit& u) const { const int L = i * G + v; if (L >= 1024) return false; u.pm = L >> 3; u.pn = L & 7; return true; }
    __device__ __forceinline__ void a_ready(const Unit&) const {}
    __device__ __forceinline__ void done(const Unit&) const {}
};
struct EpiDownNorm {
    static constexpr bool PERM = false, AFTER_DRAIN = false, MIDK = false;
    float* out; const bf16_t* h1b; const float* gfin; u64* ssfin; unsigned* cnt;
    __device__ __forceinline__ void midk(f32x4 (&)[2][2][4][2], const Unit&, int, int) const {}
    __device__ __forceinline__ void operator()(const f32x4 (&acc_c)[2][2][4][2], const Unit& u, int wr, int wc, int fr, int fq) const {
        f32x4 (&acc)[2][2][4][2] = const_cast<f32x4 (&)[2][2][4][2]>(acc_c);
        const int col0 = u.pn * BM + wc * 32 + 4 * fq;
        u64 chk = 0ull;
#pragma unroll
        for (int ai = 0; ai < 2; ++ai)
#pragma unroll
            for (int m = 0; m < 4; ++m) {
                const int r = u.pm * BM + ai * HALF + wr * 64 + m * 16 + fr; const size_t off = (size_t)r * 2048 + col0;
                float s = 0.f;
#pragma unroll
                for (int bj = 0; bj < 2; ++bj)
#pragma unroll
                    for (int n = 0; n < 2; ++n) { const u32x2 hb = *(const u32x2*)(h1b + off + bj * HALF + n * 16);
                        const f32x4 hres = (f32x4){__builtin_bit_cast(float, hb.x << 16), __builtin_bit_cast(float, hb.x & 0xffff0000u), __builtin_bit_cast(float, hb.y << 16), __builtin_bit_cast(float, hb.y & 0xffff0000u)};
                        const f32x4 h = hres + acc[ai][bj][m][n]; acc[ai][bj][m][n] = h; s += sq4(h); }
                s += __shfl_xor(s, 16); s += __shfl_xor(s, 32);
                if (fq == 0) chk ^= atomicAdd(ssfin + r, (u64)(s * FIXS));
            }
        asm volatile("s_waitcnt vmcnt(0)" : "+v"(chk) :: "memory");
        unsigned* c = cnt + 64 * u.pm;
        if (fr == 0 && fq == 0) {
            __hip_atomic_fetch_add(c, 1u, __ATOMIC_RELAXED, __HIP_MEMORY_SCOPE_AGENT);
            unsigned spins = 0;
            while (__hip_atomic_load(c, __ATOMIC_RELAXED, __HIP_MEMORY_SCOPE_AGENT) < 64u) { __builtin_amdgcn_s_sleep(2); if (++spins > (1u << 22)) break; }
        }
        asm volatile("" ::: "memory");
        f32x4 gv[2][2];
#pragma unroll
        for (int bj = 0; bj < 2; ++bj)
#pragma unroll
            for (int n = 0; n < 2; ++n) gv[bj][n] = *(const f32x4*)(gfin + col0 + bj * HALF + n * 16);
#pragma unroll
        for (int ai = 0; ai < 2; ++ai)
#pragma unroll
            for (int m = 0; m < 4; ++m) {
                const int r = u.pm * BM + ai * HALF + wr * 64 + m * 16 + fr; const size_t off = (size_t)r * 2048 + col0;
                const u64 sv = __hip_atomic_load(ssfin + r, __ATOMIC_RELAXED, __HIP_MEMORY_SCOPE_AGENT);
                const float sc = rsqrtf((float)sv * (1.0f / (FIXS * 2048.0f)) + 1e-6f);
#pragma unroll
                for (int bj = 0; bj < 2; ++bj)
#pragma unroll
                    for (int n = 0; n < 2; ++n) *(f32x4*)(out + off + bj * HALF + n * 16) = acc[ai][bj][m][n] * sc * gv[bj][n];
            }
    }
};

template <class Epi, class Sched, bool ALIGN_EPI = false, bool SP2 = false>
__device__ __forceinline__ void gemm_phase(PG8_LAS unsigned char* lds, const Gemm g, const Sched& S, const Epi& E) {
    const int tid = threadIdx.x, wid = __builtin_amdgcn_readfirstlane(tid >> 6), lane = tid & 63, wr = wid >> 2, wc = wid & 3, fr = lane & 15, fq = lane >> 4;
    const int K = g.K, nt = K / BK;
    unsigned voffA[2], voffB[2];
#pragma unroll
    for (int i = 0; i < 2; ++i) { int R, C; stage_rc(tid * 16 + i * 8192, R, C); const int Rb = Epi::PERM ? ((R & ~31) + perm32(R & 31)) : R;
        voffA[i] = (unsigned)(R * K + C) * 2u; voffB[i] = (unsigned)(Rb * K + C) * 2u; }
    const size_t kstep = (size_t)(BK * 2);
    const size_t hstep = (size_t)HALF * K * 2;
    const size_t tstep = 2 * hstep;
    const unsigned ldsw = (unsigned)wid * 1024u;
    const int aoff = lds_byte(wr * 64 + fr, fq * 8), boff = lds_byte(wc * 32 + fr, fq * 8);
#define PG8_SA(b, h) (((b) * 2 + (h)) * HTB)
#define PG8_SB(b, h) ((4 + (b) * 2 + (h)) * HTB)
#define PG8_STAGE(bufoff, gbase, voff) do { _Pragma("unroll") for (int _i = 0; _i < 2; ++_i) \
        __builtin_amdgcn_global_load_lds((const unsigned*)((const char*)(gbase) + (voff)[_i]), (PG8_LAS unsigned*)(lds + (bufoff) + ldsw + _i * 8192), 16, 0, 0); } while (0)
#define PG8_LDA(dst, b, h) do { _Pragma("unroll") for (int m = 0; m < 4; ++m) _Pragma("unroll") for (int k = 0; k < 2; ++k) dst[m][k] = *(const PG8_LAS bf16x8*)(lds + PG8_SA(b, h) + aoff + m * 2048 + k * 1024); } while (0)
#define PG8_LDB(dst, b, h) do { _Pragma("unroll") for (int n = 0; n < 2; ++n) _Pragma("unroll") for (int k = 0; k < 2; ++k) dst[n][k] = *(const PG8_LAS bf16x8*)(lds + PG8_SB(b, h) + boff + n * 2048 + k * 1024); } while (0)
#define PG8_MMA(ai, bj, At, Bt) do { __builtin_amdgcn_s_setprio(1); _Pragma("unroll") for (int m = 0; m < 4; ++m) _Pragma("unroll") for (int n = 0; n < 2; ++n) _Pragma("unroll") for (int k = 0; k < 2; ++k) \
        acc[ai][bj][m][n] = __builtin_amdgcn_mfma_f32_16x16x32_bf16(Bt[n][k], At[m][k], acc[ai][bj][m][n], 0, 0, 0); __builtin_amdgcn_s_setprio(0); } while (0)
#define PG8_WAIT_V(n) asm volatile("s_waitcnt vmcnt(" #n ")" ::: "memory")
#define PG8_WAIT_L(n) asm volatile("s_waitcnt lgkmcnt(" #n ")" ::: "memory")
#define PG8_BAR __builtin_amdgcn_s_barrier()
#define PG8_SCHED __builtin_amdgcn_sched_barrier(0)
    Unit cur, nxt; int ui = 0;
    if (!S.next(0, cur)) return;
    f32x4 acc[2][2][4][2];
#pragma unroll
    for (int a = 0; a < 2; ++a)
#pragma unroll
        for (int b = 0; b < 2; ++b)
#pragma unroll
            for (int m = 0; m < 4; ++m)
#pragma unroll
                for (int n = 0; n < 2; ++n) acc[a][b][m][n] = (f32x4){0.f, 0.f, 0.f, 0.f};
    bf16x8 At[4][2], B0[2][2], B1[2][2];
    const char* cA = (const char*)g.A + (size_t)cur.pm * tstep; const char* cB = (const char*)g.Bt + (size_t)cur.pn * tstep;
    S.a_ready(cur);
    if constexpr (SP2) {
        PG8_STAGE(PG8_SB(0, 0), cB, voffB); PG8_STAGE(PG8_SB(0, 1), cB + hstep, voffB); PG8_STAGE(PG8_SA(0, 0), cA, voffA); PG8_STAGE(PG8_SA(0, 1), cA + hstep, voffA);
        if (wr == 1) PG8_BAR;
        PG8_WAIT_V(2); PG8_BAR;
        PG8_STAGE(PG8_SB(1, 0), cB + kstep, voffB); PG8_STAGE(PG8_SA(1, 0), cA + kstep, voffA); PG8_STAGE(PG8_SB(1, 1), cB + hstep + kstep, voffB);
        PG8_WAIT_V(6); PG8_BAR;
    } else {
        PG8_STAGE(PG8_SB(0, 0), cB, voffB); PG8_STAGE(PG8_SA(0, 0), cA, voffA); PG8_STAGE(PG8_SB(0, 1), cB + hstep, voffB); PG8_STAGE(PG8_SA(0, 1), cA + hstep, voffA);
        if (wr == 1) PG8_BAR;
        PG8_WAIT_V(4); PG8_BAR;
        PG8_STAGE(PG8_SB(1, 0), cB + kstep, voffB); PG8_STAGE(PG8_SA(1, 0), cA + kstep, voffA); PG8_STAGE(PG8_SB(1, 1), cB + hstep + kstep, voffB);
        PG8_WAIT_V(6); PG8_BAR;
    }
    for (;;) {
        const bool has_next = S.next(ui + 1, nxt);
        const char* nA = has_next ? (const char*)g.A + (size_t)nxt.pm * tstep : cA; const char* nB = has_next ? (const char*)g.Bt + (size_t)nxt.pn * tstep : cB;
        for (int t = 0; t < nt; t += 2) {
            const bool last = (t == nt - 2);
            if constexpr (Epi::MIDK) { if (t == nt / 2) { const int l2 = (int)__builtin_amdgcn_mbcnt_hi(~0u, __builtin_amdgcn_mbcnt_lo(~0u, 0u)); E.midk(acc, cur, wr, l2 & 15); } }
            const char* a1 = cA + (size_t)(t + 1) * kstep;
            const char* a2 = last ? nA : cA + (size_t)(t + 2) * kstep; const char* b2 = last ? nB : cB + (size_t)(t + 2) * kstep;
            const char* a3 = a2 + kstep; const char* b3 = b2 + kstep;
            if (last && has_next) S.a_ready(nxt);
            if constexpr (SP2) {
            PG8_LDB(B0, 0, 0); PG8_LDB(B1, 0, 1); PG8_SCHED; PG8_LDA(At, 0, 0); PG8_STAGE(PG8_SA(1, 1), a1 + hstep, voffA);
            PG8_WAIT_V(8); PG8_WAIT_L(0); PG8_BAR; PG8_MMA(0, 0, At, B0); PG8_MMA(0, 1, At, B1); PG8_BAR; PG8_SCHED;
            PG8_LDA(At, 0, 1); PG8_STAGE(PG8_SB(0, 0), b2, voffB); PG8_STAGE(PG8_SB(0, 1), b2 + hstep, voffB); PG8_STAGE(PG8_SA(0, 0), a2, voffA);
            PG8_WAIT_V(8); PG8_WAIT_L(0); PG8_BAR; PG8_MMA(1, 0, At, B0); PG8_MMA(1, 1, At, B1); PG8_BAR; PG8_SCHED;
            PG8_LDB(B0, 1, 0); PG8_LDB(B1, 1, 1); PG8_SCHED; PG8_LDA(At, 1, 0); PG8_STAGE(PG8_SA(0, 1), a2 + hstep, voffA);
            PG8_WAIT_V(8); PG8_WAIT_L(0); PG8_BAR; PG8_MMA(0, 0, At, B0); PG8_MMA(0, 1, At, B1); PG8_BAR; PG8_SCHED;
            PG8_LDA(At, 1, 1); PG8_STAGE(PG8_SB(1, 0), b3, voffB); PG8_STAGE(PG8_SB(1, 1), b3 + hstep, voffB); PG8_STAGE(PG8_SA(1, 0), a3, voffA);
            PG8_WAIT_V(8); PG8_WAIT_L(0); PG8_BAR; PG8_MMA(1, 0, At, B0); PG8_MMA(1, 1, At, B1); PG8_BAR; PG8_SCHED;
            } else {
            PG8_LDB(B0, 0, 0); PG8_SCHED; PG8_LDA(At, 0, 0); PG8_STAGE(PG8_SA(1, 1), a1 + hstep, voffA);
            PG8_WAIT_L(8); PG8_BAR; PG8_WAIT_L(0); PG8_MMA(0, 0, At, B0); PG8_BAR; PG8_SCHED;
            PG8_LDB(B1, 0, 1); PG8_STAGE(PG8_SB(0, 0), b2, voffB);
            PG8_BAR; PG8_WAIT_L(0); PG8_MMA(0, 1, At, B1); PG8_BAR;
            PG8_LDA(At, 0, 1); PG8_STAGE(PG8_SA(0, 0), a2, voffA);
            PG8_BAR; PG8_WAIT_L(0); PG8_MMA(1, 0, At, B0); PG8_BAR; PG8_SCHED;
            PG8_STAGE(PG8_SB(0, 1), b2 + hstep, voffB);
            PG8_WAIT_V(6); PG8_BAR; PG8_MMA(1, 1, At, B1); PG8_BAR;
            PG8_LDB(B0, 1, 0); PG8_SCHED; PG8_LDA(At, 1, 0); PG8_STAGE(PG8_SA(0, 1), a2 + hstep, voffA);
            PG8_WAIT_L(8); PG8_BAR; PG8_WAIT_L(0); PG8_MMA(0, 0, At, B0); PG8_BAR; PG8_SCHED;
            PG8_LDB(B1, 1, 1); PG8_STAGE(PG8_SB(1, 0), b3, voffB);
            PG8_BAR; PG8_WAIT_L(0); PG8_MMA(0, 1, At, B1); PG8_BAR;
            PG8_LDA(At, 1, 1); PG8_STAGE(PG8_SA(1, 0), a3, voffA);
            PG8_BAR; PG8_WAIT_L(0); PG8_MMA(1, 0, At, B0); PG8_BAR; PG8_SCHED;
            PG8_STAGE(PG8_SB(1, 1), b3 + hstep, voffB);
            PG8_WAIT_V(6); PG8_BAR; PG8_MMA(1, 1, At, B1); PG8_BAR;
            }
        }
        if constexpr (ALIGN_EPI) { if (wr == 0) PG8_BAR; }
        if constexpr (!Epi::AFTER_DRAIN) { const int l2 = (int)__builtin_amdgcn_mbcnt_hi(~0u, __builtin_amdgcn_mbcnt_lo(~0u, 0u)); E(acc, cur, wr, wc, l2 & 15, l2 >> 4); S.done(cur); }
        if (!has_next) break;
#pragma unroll
        for (int a = 0; a < 2; ++a)
#pragma unroll
            for (int b = 0; b < 2; ++b)
#pragma unroll
                for (int m = 0; m < 4; ++m)
#pragma unroll
                    for (int n = 0; n < 2; ++n) acc[a][b][m][n] = (f32x4){0.f, 0.f, 0.f, 0.f};
        cur = nxt; cA = nA; cB = nB; ++ui;
        if constexpr (ALIGN_EPI) { if (wr == 1) PG8_BAR; }
    }
    PG8_WAIT_V(0);
    if constexpr (!ALIGN_EPI) { if (wr == 0) PG8_BAR; }
    PG8_BAR;
    if constexpr (Epi::AFTER_DRAIN) { E.fused(acc, cur, wr, wc, fr, fq, lds, wid, lane); S.done(cur); }
#undef PG8_SA
#undef PG8_SB
#undef PG8_STAGE
#undef PG8_LDA
#undef PG8_LDB
#undef PG8_MMA
#undef PG8_WAIT_V
#undef PG8_WAIT_L
#undef PG8_BAR
#undef PG8_SCHED
}
}

constexpr int NB = 16, SEQ = 2048, DM = 2048, LP = 2112, MROWS = NB * SEQ, MPAD = NB * LP, FFN = 8192;
constexpr int NIN = 5120, NINV = 4928;
constexpr int NPOS = 2064;
constexpr float EPSN = 1e-6f;
constexpr float FIXS = 16777216.0f;
constexpr size_t MiB = 1u << 20;
constexpr size_t WS_SSQ = 0, WS_SSKV = 512 * 1024, WS_SSMLA = 1 * MiB, WS_SSH1 = 1 * MiB + 512 * 1024;
constexpr size_t WS_ROPE = 2 * MiB;
constexpr size_t WS_WIN = 4 * MiB, WS_WUQ = 24 * MiB, WS_WUK = 26 * MiB, WS_WUV = 27 * MiB, WS_WO = 28 * MiB, WS_WUP = 36 * MiB, WS_WDN = 68 * MiB;
constexpr size_t WS_XN = 100 * MiB;
constexpr size_t WS_HID = 228 * MiB;
constexpr size_t WS_RQ = 228 * MiB, WS_RG = 292 * MiB, WS_RK = 356 * MiB, WS_RV = 422 * MiB, WS_CQ = 488 * MiB, WS_CKV = 520 * MiB, WS_KRAW = 537 * MiB, WS_KR2 = 542 * MiB;
constexpr size_t WS_Q = 547 * MiB, WS_KN = 643 * MiB, WS_VT = 709 * MiB, WS_A2 = 775 * MiB, WS_END = 903 * MiB;
static_assert(WS_HID + (size_t)MROWS * FFN * 2 <= WS_A2, "hid must not overlay A2");
constexpr int LDS_BYTES = 147456;
#define LAS __attribute__((address_space(3)))
typedef unsigned short bf16;
typedef unsigned v4u __attribute__((ext_vector_type(4)));
typedef unsigned v2u __attribute__((ext_vector_type(2)));
typedef float f32x4 __attribute__((ext_vector_type(4)));
typedef float f32x2 __attribute__((ext_vector_type(2)));
__device__ __forceinline__ unsigned f2bf(float f) { unsigned u = __builtin_bit_cast(unsigned, f); return (u + 0x7fffu + ((u >> 16) & 1u)) >> 16; }
__device__ __forceinline__ unsigned pk2(float lo, float hi) { return f2bf(lo) | (f2bf(hi) << 16); }
__device__ __forceinline__ float bf2f(unsigned short h) { return __builtin_bit_cast(float, (unsigned)h << 16); }
__device__ __forceinline__ float wave_sum(float v) {
#pragma unroll
    for (int o = 1; o < 64; o <<= 1) v += __shfl_xor(v, o);
    return v;
}
#define LDS_WAIT() asm volatile("s_waitcnt lgkmcnt(0)" ::: "memory")

__device__ __forceinline__ void p0_transpose_item(const float* W, int K, int Nsrc, int koff, const float* gain, int gain_lim, float cscale, bf16* WT, LAS float* scr, int kb, int nb, int lane) {
    const int k0 = 64 * kb, n0 = 64 * nb; const bool valid = n0 < Nsrc;
#pragma unroll 16
    for (int kk = 0; kk < 64; ++kk) {
        const int kd = k0 + kk; int ks = kd + koff; if (ks >= K) ks -= K;
        const float v = valid ? W[(size_t)ks * Nsrc + n0 + lane] : 0.f;
        const float g = (gain != nullptr && kd < gain_lim) ? gain[kd] : 1.f;
        scr[kk * 65 + lane] = v * g * cscale;
    }
    LDS_WAIT(); asm volatile("" ::: "memory");
    const int c = lane & 7;
#pragma unroll
    for (int j = 0; j < 8; ++j) { const int n = (lane >> 3) + 8 * j; const LAS float* s = scr + (8 * c) * 65 + n;
        v4u o; o.x = pk2(s[0 * 65], s[1 * 65]); o.y = pk2(s[2 * 65], s[3 * 65]); o.z = pk2(s[4 * 65], s[5 * 65]); o.w = pk2(s[6 * 65], s[7 * 65]);
        *(v4u*)(WT + (size_t)(n0 + n) * K + k0 + 8 * c) = o; }
    LDS_WAIT(); asm volatile("" ::: "memory");
}
__device__ __forceinline__ void rms_rows2_to_bf16(const float* xrow0, const float* xrow1, const float* g, bf16* orow0, bf16* orow1, int lane) {
    const f32x4* xr0 = (const f32x4*)xrow0 + lane; const f32x4* xr1 = (const f32x4*)xrow1 + lane; const f32x4* gr = (const f32x4*)g + lane;
    f32x4 v0[8], v1[8]; float s0 = 0.f, s1 = 0.f;
#pragma unroll
    for (int j = 0; j < 8; ++j) { v0[j] = xr0[64 * j]; v1[j] = xr1[64 * j]; }
#pragma unroll
    for (int j = 0; j < 8; ++j) { s0 += (v0[j].x * v0[j].x + v0[j].y * v0[j].y) + (v0[j].z * v0[j].z + v0[j].w * v0[j].w); s1 += (v1[j].x * v1[j].x + v1[j].y * v1[j].y) + (v1[j].z * v1[j].z + v1[j].w * v1[j].w); }
    const float r0 = rsqrtf(wave_sum(s0) * (1.f / 2048.f) + EPSN), r1 = rsqrtf(wave_sum(s1) * (1.f / 2048.f) + EPSN);
    v2u* o0 = (v2u*)orow0 + lane; v2u* o1 = (v2u*)orow1 + lane;
#pragma unroll
    for (int j = 0; j < 8; ++j) { const f32x4 gv = gr[64 * j];
        v2u a; a.x = pk2(v0[j].x * r0 * gv.x, v0[j].y * r0 * gv.y); a.y = pk2(v0[j].z * r0 * gv.z, v0[j].w * r0 * gv.w); o0[64 * j] = a;
        v2u b; b.x = pk2(v1[j].x * r1 * gv.x, v1[j].y * r1 * gv.y); b.y = pk2(v1[j].z * r1 * gv.z, v1[j].w * r1 * gv.w); o1[64 * j] = b; }
}
template <int NJ> __device__ __forceinline__ void p0_meta_item(const float* meta, const float* g, const float* w_in, int c0, int ncols, bf16* dst, int ld, int dcol0, u64* sskv, LAS unsigned char* lds, int wave, int lane) {
    LAS float* U = (LAS float*)lds;
#pragma unroll 1
    for (int rr = 0; rr < 2; ++rr) {
        const int row = 2 * wave + rr; const float* mr = meta + (size_t)row * 2048;
        float s = 0.f;
        for (int j = 0; j < 32; ++j) { const float v = mr[lane + 64 * j]; s += v * v; }
        const float rstd = rsqrtf(wave_sum(s) * (1.f / 2048.f) + EPSN);
        for (int j = 0; j < 32; ++j) { const int k = lane + 64 * j; U[row * 2048 + k] = mr[k] * rstd * g[k]; }
    }
    __syncthreads();
    float acc[16][NJ];
#pragma unroll
    for (int r = 0; r < 16; ++r)
#pragma unroll
        for (int j = 0; j < NJ; ++j) acc[r][j] = 0.f;
    const int kb = 256 * wave;
#pragma unroll 1
    for (int k = kb; k < kb + 256; k += 8) {
        float w[8][NJ];
#pragma unroll
        for (int u = 0; u < 8; ++u)
#pragma unroll
            for (int j = 0; j < NJ; ++j) { const int cc = lane + 64 * j; w[u][j] = (cc < ncols) ? w_in[(size_t)(k + u) * NINV + c0 + cc] : 0.f; }
#pragma unroll
        for (int r = 0; r < 16; ++r) {
            const f32x4 u0 = *(const LAS f32x4*)(U + r * 2048 + k), u1 = *(const LAS f32x4*)(U + r * 2048 + k + 4);
#pragma unroll
            for (int j = 0; j < NJ; ++j) acc[r][j] += (u0[0] * w[0][j] + u0[1] * w[1][j]) + (u0[2] * w[2][j] + u0[3] * w[3][j]) + (u1[0] * w[4][j] + u1[1] * w[5][j]) + (u1[2] * w[6][j] + u1[3] * w[7][j]);
        }
    }
    __syncthreads();
    LAS float* P = (LAS float*)lds;
#pragma unroll
    for (int r = 0; r < 16; ++r)
#pragma unroll
        for (int j = 0; j < NJ; ++j) P[(wave * 16 + r) * 256 + lane + 64 * j] = acc[r][j];
    __syncthreads();
#pragma unroll 1
    for (int rr = 0; rr < 2; ++rr) {
        const int row = 2 * wave + rr; float v[NJ]; float s = 0.f;
#pragma unroll
        for (int j = 0; j < NJ; ++j) { float t = 0.f;
#pragma unroll
            for (int w8 = 0; w8 < 8; ++w8) t += P[(w8 * 16 + row) * 256 + lane + 64 * j];
            v[j] = t; s += t * t; }
        s = wave_sum(s);
        for (int b = 0; b < NB; ++b) {
            const size_t rp = (size_t)b * LP + 48 + row;
#pragma unroll
            for (int j = 0; j < NJ; ++j) { const int cc = lane + 64 * j; if (cc < ncols) dst[rp * ld + dcol0 + cc] = (bf16)f2bf(v[j]); }
            if (sskv != nullptr && lane == 0) sskv[rp] = (u64)(s * FIXS);
        }
    }
    __syncthreads();
}

__device__ __forceinline__ void ret_naive(const bf16* RQ, const bf16* RK, const bf16* RV, const bf16* RG, const f32x2* ROPE, const float* retg, bf16* A2, int gw, int ngw, int lane) {
    for (int it = gw; it < NB * 8 * SEQ; it += ngw) {
        const int s = it & 2047, h = (it >> 11) & 7, b = it >> 14;
        const int r = b * SEQ + s, cn = 1 + (s >> 6), nabs = 64 + s;
        const float lg = log2f(1.0f - exp2f(-5.0f - (float)h));
        float q1 = bf2f(RQ[(size_t)r * 1024 + h * 128 + lane]), q2 = bf2f(RQ[(size_t)r * 1024 + h * 128 + 64 + lane]);
        { const f32x2 cs = ROPE[(16 + s) * 64 + lane]; const float a = q1 * cs.x - q2 * cs.y, c = q1 * cs.y + q2 * cs.x; q1 = a * 0.08838834764831845f; q2 = c * 0.08838834764831845f; }
        float o1 = 0.f, o2 = 0.f;
        const int pend = 64 * (cn + 1);
        for (int p = 48; p < pend; ++p) {
            const size_t rp = (size_t)b * LP + p;
            float k1 = bf2f(RK[rp * 1024 + h * 128 + lane]), k2 = bf2f(RK[rp * 1024 + h * 128 + 64 + lane]);
            const f32x2 cs = ROPE[(p - 48) * 64 + lane];
            const float ka = k1 * cs.x - k2 * cs.y, kc = k1 * cs.y + k2 * cs.x;
            const float d = wave_sum(q1 * ka + q2 * kc);
            const int dist = ((p >> 6) == cn) ? (nabs > p ? nabs - p : p - nabs) : (nabs - p);
            const float w = d * exp2f(lg * (float)dist);
            o1 += w * bf2f(RV[rp * 1024 + h * 128 + lane]); o2 += w * bf2f(RV[rp * 1024 + h * 128 + 64 + lane]);
        }
        const float mu = wave_sum(o1 + o2) * (1.f / 128.f);
        const float d1 = o1 - mu, d2 = o2 - mu;
        const float var = wave_sum(d1 * d1 + d2 * d2) * (1.f / 128.f);
        const float rs = rsqrtf(var + EPSN);
        const float g1 = bf2f(RG[(size_t)r * 1024 + h * 128 + lane]), g2 = bf2f(RG[(size_t)r * 1024 + h * 128 + 64 + lane]);
        const float y1 = d1 * rs * retg[h * 128 + lane] * (g1 / (1.f + __expf(-g1))), y2 = d2 * rs * retg[h * 128 + 64 + lane] * (g2 / (1.f + __expf(-g2)));
        A2[(size_t)r * 2048 + 1024 + h * 128 + lane] = (bf16)f2bf(y1); A2[(size_t)r * 2048 + 1024 + h * 128 + 64 + lane] = (bf16)f2bf(y2);
    }
}
__device__ __forceinline__ void mla_naive(const bf16* Q, const bf16* KN, const bf16* KR2, const bf16* VT, const f32x2* ROPE, bf16* A2, u64* ssmla, int gw, int ngw, int lane) {
    for (int it = gw; it < NB * 8 * SEQ; it += ngw) {
        const int s = it & 2047, h = (it >> 11) & 7, b = it >> 14;
        const int r = b * SEQ + s, cn = 1 + (s >> 6);
        const bf16* qb = Q + (size_t)r * 1536 + h * 192;
        const float q1 = bf2f(qb[lane]), q2 = bf2f(qb[64 + lane]);
        float qr1 = 0.f, qr2 = 0.f;
        if (lane < 32) { const float a = bf2f(qb[128 + lane]), c = bf2f(qb[160 + lane]); const f32x2 cs = ROPE[(16 + s) * 64 + 2 * lane]; qr1 = a * cs.x - c * cs.y; qr2 = a * cs.y + c * cs.x; }
        float m = -1e30f, l = 0.f, o1 = 0.f, o2 = 0.f;
        const int pend = 64 * (cn + 1);
        for (int p = 48; p < pend; ++p) {
            const size_t rp = (size_t)b * LP + p;
            float t = q1 * bf2f(KN[rp * 1024 + h * 128 + lane]) + q2 * bf2f(KN[rp * 1024 + h * 128 + 64 + lane]);
            if (lane < 32) t += qr1 * bf2f(KR2[rp * 64 + lane]) + qr2 * bf2f(KR2[rp * 64 + 32 + lane]);
            const float sc = wave_sum(t);
            const float mn = fmaxf(m, sc), al = exp2f(m - mn), pw = exp2f(sc - mn);
            l = l * al + pw;
            o1 = o1 * al + pw * bf2f(VT[(size_t)(h * 128 + lane) * MPAD + rp]); o2 = o2 * al + pw * bf2f(VT[(size_t)(h * 128 + 64 + lane) * MPAD + rp]);
            m = mn;
        }
        const float il = 1.f / l; o1 *= il; o2 *= il;
        const float ss = wave_sum(o1 * o1 + o2 * o2);
        if (lane == 0) atomicAdd(ssmla + r, (u64)(ss * FIXS));
        A2[(size_t)r * 2048 + h * 128 + lane] = (bf16)f2bf(o1); A2[(size_t)r * 2048 + h * 128 + 64 + lane] = (bf16)f2bf(o2);
    }
}

typedef float f32x16 __attribute__((ext_vector_type(16)));
typedef short bf16x8 __attribute__((ext_vector_type(8)));
typedef short bf16x4 __attribute__((ext_vector_type(4)));
__device__ __forceinline__ f32x16 mfma32(bf16x8 a, bf16x8 b, f32x16 c) { return __builtin_amdgcn_mfma_f32_32x32x16_bf16(a, b, c, 0, 0, 0); }
__device__ __forceinline__ unsigned cvtpk(float lo, float hi) { unsigned r; asm volatile("v_cvt_pk_bf16_f32 %0, %1, %2" : "=v"(r) : "v"(lo), "v"(hi)); return r; }
__device__ __forceinline__ bf16x8 pack8f(float a0, float a1, float a2, float a3, float a4, float a5, float a6, float a7) {
    v4u w; w.x = cvtpk(a0, a1); w.y = cvtpk(a2, a3); w.z = cvtpk(a4, a5); w.w = cvtpk(a6, a7); return __builtin_bit_cast(bf16x8, w); }
__device__ __forceinline__ bf16x8 cat44(bf16x4 a, bf16x4 b) { return __builtin_shufflevector(a, b, 0, 1, 2, 3, 4, 5, 6, 7); }
__device__ __forceinline__ float ex2(float x) { return __builtin_amdgcn_exp2f(x); }

constexpr int ATT_KROW = 400, ATT_KBYTES = 64 * ATT_KROW, ATT_VROW = 144, ATT_VBYTES = 128 * ATT_VROW, ATT_BUF = ATT_KBYTES + ATT_VBYTES;
__device__ __forceinline__ void mla_unit(LAS unsigned char* lds, const bf16* Q, const bf16* KN, const bf16* KR2, const bf16* VT, const f32x2* ROPE, bf16* A2, u64* ssmla, int b, int h, int qblk, int tid) {
    const int lane = tid & 63, wave = __builtin_amdgcn_readfirstlane(tid >> 6), l31 = lane & 31, hi = lane >> 5;
    const int sq = qblk * 256 + wave * 32 + l31;
    const size_t rq = (size_t)b * SEQ + sq;
    bf16x8 qf[12];
    { const bf16* qp = Q + rq * 1536 + h * 192 + 8 * hi;
#pragma unroll
      for (int kk = 0; kk < 12; ++kk) qf[kk] = *(const bf16x8*)(qp + 16 * kk);
#pragma unroll
      for (int k2 = 0; k2 < 2; ++k2)
#pragma unroll
          for (int j = 0; j < 8; ++j) { const int t = 16 * k2 + 8 * hi + j; const f32x2 cs = ROPE[(16 + sq) * 64 + 2 * t];
              const float x1 = bf2f((unsigned short)qf[8 + k2][j]), x2 = bf2f((unsigned short)qf[10 + k2][j]);
              qf[8 + k2][j] = (short)f2bf(x1 * cs.x - x2 * cs.y); qf[10 + k2][j] = (short)f2bf(x1 * cs.y + x2 * cs.x); } }
    const int ntiles = 4 * qblk + 5, ktmax = 4 * qblk + 1 + (wave >> 1);
    const size_t prow0 = (size_t)b * LP;
    v4u st[5];
#define ATT_ADDR() int tq_ = tid; asm volatile("" : "+v"(tq_)); const int kkey0 = tq_ >> 4, kpc = tq_ & 15, rkey = tq_ >> 3, rpc = tq_ & 7; \
        const bf16* gkn = KN + (prow0 + kkey0) * 1024 + h * 128 + kpc * 8; const bf16* gkr = KR2 + (prow0 + rkey) * 64 + rpc * 8; const bf16* gvt = VT + (size_t)(h * 128 + rkey) * MPAD + prow0 + rpc * 8
#define ATT_LOAD(kt) do { ATT_ADDR(); st[0] = *(const v4u*)(gkn + (size_t)(kt) * 65536); st[1] = *(const v4u*)(gkn + (size_t)(kt) * 65536 + 32768); st[2] = *(const v4u*)(gkr + (size_t)(kt) * 4096); \
        st[3] = *(const v4u*)(gvt + (kt) * 64); st[4] = *(const v4u*)(gvt + (size_t)64 * MPAD + (kt) * 64); } while (0)
#define ATT_WRITE(bo) do { int tw_ = tid; asm volatile("" : "+v"(tw_)); const int lkn = (tw_ >> 4) * ATT_KROW + (tw_ & 15) * 16, lkr = (tw_ >> 3) * ATT_KROW + 256 + (tw_ & 7) * 16, lvt = ATT_KBYTES + (tw_ >> 3) * ATT_VROW + ((tw_ & 7) >> 1) * 32 + (tw_ & 1) * 8; \
        LAS unsigned char* w_ = lds + (bo); *(LAS v4u*)(w_ + lkn) = st[0]; *(LAS v4u*)(w_ + lkn + 32 * ATT_KROW) = st[1]; *(LAS v4u*)(w_ + lkr) = st[2]; \
        *(LAS v2u*)(w_ + lvt) = (v2u){st[3].x, st[3].y}; *(LAS v2u*)(w_ + lvt + 16) = (v2u){st[3].z, st[3].w}; \
        *(LAS v2u*)(w_ + lvt + 64 * ATT_VROW) = (v2u){st[4].x, st[4].y}; *(LAS v2u*)(w_ + lvt + 64 * ATT_VROW + 16) = (v2u){st[4].z, st[4].w}; } while (0)
    f32x16 oacc[4];
#pragma unroll
    for (int e = 0; e < 4; ++e)
#pragma unroll
        for (int r = 0; r < 16; ++r) oacc[e][r] = 0.f;
    float m = 0.f, l = 0.f;
    ATT_LOAD(0); ATT_WRITE(0); __syncthreads();
#pragma unroll 1
    for (int kt = 0; kt < ntiles; ++kt) {
        const int bo = (kt & 1) * ATT_BUF;
        int tl_ = lane; asm volatile("" : "+v"(tl_)); const int koff = (tl_ & 31) * ATT_KROW + (tl_ >> 5) * 16, voff = ATT_KBYTES + (tl_ & 31) * ATT_VROW + (tl_ >> 5) * 16;
        if (kt + 1 < ntiles) ATT_LOAD(kt + 1);
        if (kt <= ktmax) {
            f32x16 s0, s1;
#pragma unroll
            for (int r = 0; r < 16; ++r) { s0[r] = -m; s1[r] = -m; }
            bf16x8 ka[2][2], kb[2][2];
#define ATT_KLD(bi, kk0) do { ka[bi][0] = *(const LAS bf16x8*)(lds + bo + koff + (kk0) * 32); kb[bi][0] = *(const LAS bf16x8*)(lds + bo + koff + 32 * ATT_KROW + (kk0) * 32); \
        ka[bi][1] = *(const LAS bf16x8*)(lds + bo + koff + (kk0) * 32 + 32); kb[bi][1] = *(const LAS bf16x8*)(lds + bo + koff + 32 * ATT_KROW + (kk0) * 32 + 32); } while (0)
            ATT_KLD(0, 0);
            __builtin_amdgcn_sched_barrier(0);
#pragma unroll
            for (int bt = 0; bt < 6; ++bt) {
                if (bt < 5) ATT_KLD((bt + 1) & 1, 2 * (bt + 1));
                __builtin_amdgcn_sched_barrier(0);
                s0 = mfma32(ka[bt & 1][0], qf[2 * bt], s0); s1 = mfma32(kb[bt & 1][0], qf[2 * bt], s1);
                s0 = mfma32(ka[bt & 1][1], qf[2 * bt + 1], s0); s1 = mfma32(kb[bt & 1][1], qf[2 * bt + 1], s1);
                __builtin_amdgcn_sched_barrier(0);
            }
#undef ATT_KLD
            if (kt == 0) {
                asm volatile("" ::: "memory");
#pragma unroll
                for (int r = 0; r < 16; ++r) s0[r] = -1e30f;
#pragma unroll
                for (int r = 0; r < 8; ++r) s1[r] = -1e30f;
            }
            float mxa, mxb;
            asm("v_max3_f32 %0, %1, %2, %3" : "=v"(mxa) : "v"(s0[0]), "v"(s0[1]), "v"(s0[2]));
            asm("v_max3_f32 %0, %1, %2, %3" : "=v"(mxb) : "v"(s1[0]), "v"(s1[1]), "v"(s1[2]));
#pragma unroll
            for (int r = 3; r < 15; r += 2) { asm("v_max3_f32 %0, %1, %2, %3" : "=v"(mxa) : "v"(mxa), "v"(s0[r]), "v"(s0[r + 1])); asm("v_max3_f32 %0, %1, %2, %3" : "=v"(mxb) : "v"(mxb), "v"(s1[r]), "v"(s1[r + 1])); }
            float mx; asm("v_max3_f32 %0, %1, %2, %3" : "=v"(mx) : "v"(mxa), "v"(mxb), "v"(s0[15]));
            mx = fmaxf(mx, s1[15]);
            mx = fmaxf(mx, __shfl_xor(mx, 32));
            if (kt == 0 || __builtin_amdgcn_ballot_w64(mx > 8.0f) != 0ull) {
                const float sh = kt == 0 ? mx : fmaxf(mx, 0.f), al = ex2(-sh); m += sh;
                l *= al;
#pragma unroll
                for (int r = 0; r < 16; ++r) { s0[r] -= sh; s1[r] -= sh; }
#pragma unroll
                for (int e = 0; e < 4; ++e)
#pragma unroll
                    for (int r = 0; r < 16; ++r) oacc[e][r] *= al;
            }
            float ps = 0.f;
#pragma unroll
            for (int r = 0; r < 16; ++r) { s0[r] = ex2(s0[r]); s1[r] = ex2(s1[r]); ps += s0[r] + s1[r]; }
            l += ps;
            bf16x8 pb[4];
            pb[0] = pack8f(s0[0], s0[1], s0[2], s0[3], s0[4], s0[5], s0[6], s0[7]); pb[1] = pack8f(s0[8], s0[9], s0[10], s0[11], s0[12], s0[13], s0[14], s0[15]);
            pb[2] = pack8f(s1[0], s1[1], s1[2], s1[3], s1[4], s1[5], s1[6], s1[7]); pb[3] = pack8f(s1[8], s1[9], s1[10], s1[11], s1[12], s1[13], s1[14], s1[15]);
            bf16x8 vv[2][4];
#define ATT_VLD(bi, t) do { _Pragma("unroll") for (int e = 0; e < 4; ++e) vv[bi][e] = *(const LAS bf16x8*)(lds + bo + voff + e * 32 * ATT_VROW + (t) * 32); } while (0)
            ATT_VLD(0, 0);
            __builtin_amdgcn_sched_barrier(0);
#pragma unroll
            for (int t = 0; t < 4; ++t) {
                if (t < 3) ATT_VLD((t + 1) & 1, t + 1);
                __builtin_amdgcn_sched_barrier(0);
#pragma unroll
                for (int e = 0; e < 4; ++e) oacc[e] = mfma32(vv[t & 1][e], pb[t], oacc[e]);
                __builtin_amdgcn_sched_barrier(0);
            }
#undef ATT_VLD
        }
        if (kt + 1 < ntiles) ATT_WRITE(((kt + 1) & 1) * ATT_BUF);
        __syncthreads();
    }
#undef ATT_LOAD
#undef ATT_WRITE
#undef ATT_ADDR
    l += __shfl_xor(l, 32);
    const float il = 1.f / l;
    float ss = 0.f;
    bf16* op = A2 + rq * 2048 + h * 128 + 4 * hi;
#pragma unroll
    for (int e = 0; e < 4; ++e)
#pragma unroll
        for (int g4 = 0; g4 < 4; ++g4) {
            const float o0 = oacc[e][4 * g4] * il, o1 = oacc[e][4 * g4 + 1] * il, o2 = oacc[e][4 * g4 + 2] * il, o3 = oacc[e][4 * g4 + 3] * il;
            ss += (o0 * o0 + o1 * o1) + (o2 * o2 + o3 * o3);
            *(v2u*)(op + 32 * e + 8 * g4) = (v2u){cvtpk(o0, o1), cvtpk(o2, o3)};
        }
    ss += __shfl_xor(ss, 32);
    if (hi == 0) atomicAdd(ssmla + rq, (u64)(ss * FIXS));
}

constexpr int RT_ROW = 272, RT_TROW = 144, RT_QS = 0, RT_KS = 64 * RT_ROW, RT_KT = 2 * 64 * RT_ROW, RT_VT = RT_KT + 128 * RT_TROW, RT_ST = RT_VT + 128 * RT_TROW, RT_DT = RT_ST + 2048;
__device__ __forceinline__ void ret_unit(LAS unsigned char* lds, const bf16* RQ, const bf16* RK, const bf16* RV, const bf16* RG, const f32x2* ROPE, const float* retg, bf16* A2, int b, int h, int tid) {
    const int lane = tid & 63, wave = __builtin_amdgcn_readfirstlane(tid >> 6), l31 = lane & 31, hi = lane >> 5, eb = wave & 3, ib = wave >> 2;
    const float lg = log2f(1.0f - exp2f(-5.0f - (float)h));
    const float dec64 = ex2(lg * 64.0f);
    const int sj = tid & 63, spc = wave;
    f32x16 S[4];
#pragma unroll
    for (int d = 0; d < 4; ++d)
#pragma unroll
        for (int r = 0; r < 16; ++r) S[d][r] = 0.f;
    v4u rk0, rk1, rv0, rv1, rq0 = (v4u){0u, 0u, 0u, 0u}, rq1 = (v4u){0u, 0u, 0u, 0u}; f32x4 cs[4];
#define RT_LOAD(n) do { const size_t rowp_ = (size_t)b * LP + 64 * (n) + sj; const bf16* kp_ = RK + rowp_ * 1024 + h * 128 + 8 * spc; const bf16* vp_ = RV + rowp_ * 1024 + h * 128 + 8 * spc; \
        rk0 = *(const v4u*)kp_; rk1 = *(const v4u*)(kp_ + 64); rv0 = *(const v4u*)vp_; rv1 = *(const v4u*)(vp_ + 64); \
        if ((n) >= 1) { const bf16* qp_ = RQ + ((size_t)b * SEQ + 64 * ((n) - 1) + sj) * 1024 + h * 128 + 8 * spc; rq0 = *(const v4u*)qp_; rq1 = *(const v4u*)(qp_ + 64); } \
        const int p_ = 64 * (n) + sj; const int pos_ = p_ < 48 ? 0 : p_ - 48; const f32x4* cp_ = (const f32x4*)(ROPE + pos_ * 64 + 8 * spc); cs[0] = cp_[0]; cs[1] = cp_[1]; cs[2] = cp_[2]; cs[3] = cp_[3]; } while (0)
    if (tid < 127) { const int dx = tid < 63 ? 63 - tid : tid - 63; *(LAS float*)(lds + RT_DT + 4 * tid) = ex2(lg * (float)dx); }
    RT_LOAD(0);
#pragma unroll 1
    for (int n = 0; n <= 32; ++n) {
        int tq = tid; asm volatile("" : "+v"(tq));
        const int lane = tq & 63, l31 = lane & 31, hi = lane >> 5, sj = lane, spc = wave;
        const float wk = ex2(lg * (float)(63 - sj));
        {
            const bf16x8 v0v = __builtin_bit_cast(bf16x8, rv0), v1v = __builtin_bit_cast(bf16x8, rv1);
#pragma unroll
            for (int e = 0; e < 8; ++e) {
                *(LAS unsigned short*)(lds + RT_VT + (8 * spc + e) * RT_TROW + 2 * sj) = (unsigned short)v0v[e];
                *(LAS unsigned short*)(lds + RT_VT + (64 + 8 * spc + e) * RT_TROW + 2 * sj) = (unsigned short)v1v[e];
            }
        }
        __builtin_amdgcn_sched_barrier(0);
        {
            float ka[8], kb[8];
            const bf16x8 k0v = __builtin_bit_cast(bf16x8, rk0), k1v = __builtin_bit_cast(bf16x8, rk1);
#pragma unroll
            for (int e = 0; e < 8; ++e) {
                const float c = cs[e >> 1][2 * (e & 1)], s = cs[e >> 1][2 * (e & 1) + 1];
                const float k1 = bf2f((unsigned short)k0v[e]), k2 = bf2f((unsigned short)k1v[e]);
                ka[e] = k1 * c - k2 * s; kb[e] = k1 * s + k2 * c;
            }
            *(LAS bf16x8*)(lds + RT_KS + sj * RT_ROW + 16 * spc) = pack8f(ka[0], ka[1], ka[2], ka[3], ka[4], ka[5], ka[6], ka[7]);
            *(LAS bf16x8*)(lds + RT_KS + sj * RT_ROW + 128 + 16 * spc) = pack8f(kb[0], kb[1], kb[2], kb[3], kb[4], kb[5], kb[6], kb[7]);
#pragma unroll
            for (int e = 0; e < 8; ++e) {
                const unsigned pk_ = cvtpk(ka[e] * wk, kb[e] * wk);
                *(LAS unsigned short*)(lds + RT_KT + (8 * spc + e) * RT_TROW + 2 * sj) = (unsigned short)(pk_ & 0xffffu);
                *(LAS unsigned short*)(lds + RT_KT + (64 + 8 * spc + e) * RT_TROW + 2 * sj) = (unsigned short)(pk_ >> 16);
            }
        }
        __builtin_amdgcn_sched_barrier(0);
        {
            float qa[8], qb[8];
            const bf16x8 q0v = __builtin_bit_cast(bf16x8, rq0), q1v = __builtin_bit_cast(bf16x8, rq1);
#pragma unroll
            for (int e = 0; e < 8; ++e) {
                const float c = cs[e >> 1][2 * (e & 1)], s = cs[e >> 1][2 * (e & 1) + 1];
                const float q1 = bf2f((unsigned short)q0v[e]), q2 = bf2f((unsigned short)q1v[e]);
                qa[e] = (q1 * c - q2 * s) * 0.08838834764831845f; qb[e] = (q1 * s + q2 * c) * 0.08838834764831845f;
            }
            *(LAS bf16x8*)(lds + RT_QS + sj * RT_ROW + 16 * spc) = pack8f(qa[0], qa[1], qa[2], qa[3], qa[4], qa[5], qa[6], qa[7]);
            *(LAS bf16x8*)(lds + RT_QS + sj * RT_ROW + 128 + 16 * spc) = pack8f(qb[0], qb[1], qb[2], qb[3], qb[4], qb[5], qb[6], qb[7]);
        }
        asm volatile("s_waitcnt lgkmcnt(0)" ::: "memory"); __builtin_amdgcn_s_barrier(); asm volatile("" ::: "memory");
        v2u grv[4]; f32x4 gnv[4];
        { const float* rgp = retg; asm volatile("" : "+s"(rgp));
          const size_t rowq_ = (size_t)b * SEQ + 64 * (n >= 1 ? n - 1 : 0) + 32 * ib + l31;
#pragma unroll
          for (int g4 = 0; g4 < 4; ++g4) { const int e0 = h * 128 + 32 * eb + 8 * g4 + 4 * hi; gnv[g4] = *(const f32x4*)(rgp + e0); grv[g4] = *(const v2u*)(RG + rowq_ * 1024 + e0); } }
        f32x16 o;
        if (n >= 1) {
            f32x16 s0, s1;
#pragma unroll
            for (int r = 0; r < 16; ++r) { s0[r] = 0.f; s1[r] = 0.f; }
#pragma unroll
            for (int kk = 0; kk < 8; ++kk) {
                const bf16x8 qv = *(const LAS bf16x8*)(lds + RT_QS + (32 * ib + l31) * RT_ROW + kk * 32 + hi * 16);
                const bf16x8 a0 = *(const LAS bf16x8*)(lds + RT_KS + l31 * RT_ROW + kk * 32 + hi * 16), a1 = *(const LAS bf16x8*)(lds + RT_KS + (32 + l31) * RT_ROW + kk * 32 + hi * 16);
                s0 = mfma32(a0, qv, s0); s1 = mfma32(a1, qv, s1);
            }
            const int iq = 32 * ib + l31;
            {
                const LAS float* dt = (const LAS float*)(lds + RT_DT) + (iq - 4 * hi + 63);
#pragma unroll
                for (int r = 0; r < 16; ++r) { const int c = (r & 3) + 8 * (r >> 2); s0[r] *= dt[-c]; s1[r] *= dt[-c - 32]; }
            }
            bf16x8 pb[4];
            pb[0] = pack8f(s0[0], s0[1], s0[2], s0[3], s0[4], s0[5], s0[6], s0[7]); pb[1] = pack8f(s0[8], s0[9], s0[10], s0[11], s0[12], s0[13], s0[14], s0[15]);
            pb[2] = pack8f(s1[0], s1[1], s1[2], s1[3], s1[4], s1[5], s1[6], s1[7]); pb[3] = pack8f(s1[8], s1[9], s1[10], s1[11], s1[12], s1[13], s1[14], s1[15]);
            f32x16 oI, oX;
#pragma unroll
            for (int r = 0; r < 16; ++r) { oI[r] = 0.f; oX[r] = 0.f; }
#pragma unroll
            for (int t = 0; t < 4; ++t) {
                const bf16x4 vlo = *(const LAS bf16x4*)(lds + RT_VT + (32 * eb + l31) * RT_TROW + t * 32 + hi * 8), vhi = *(const LAS bf16x4*)(lds + RT_VT + (32 * eb + l31) * RT_TROW + t * 32 + 16 + hi * 8);
                oI = mfma32(cat44(vlo, vhi), pb[t], oI);
            }
#pragma unroll
            for (int db = 0; db < 4; ++db)
#pragma unroll
                for (int t = 0; t < 2; ++t) {
                    const bf16x8 sa = pack8f(S[db][8 * t], S[db][8 * t + 1], S[db][8 * t + 2], S[db][8 * t + 3], S[db][8 * t + 4], S[db][8 * t + 5], S[db][8 * t + 6], S[db][8 * t + 7]);
                    const bf16x4 qlo = *(const LAS bf16x4*)(lds + RT_QS + iq * RT_ROW + (32 * db + 16 * t + 4 * hi) * 2), qhi = *(const LAS bf16x4*)(lds + RT_QS + iq * RT_ROW + (32 * db + 16 * t + 8 + 4 * hi) * 2);
                    oX = mfma32(sa, cat44(qlo, qhi), oX);
                }
            const float wq = ex2(lg * (float)(iq + 1));
#pragma unroll
            for (int r = 0; r < 16; ++r) o[r] = oI[r] + wq * oX[r];
        }
        if (n < 32) RT_LOAD(n + 1);
        if (n < 32) {
#pragma unroll
            for (int db = 0; db < 4; ++db) {
#pragma unroll
                for (int r = 0; r < 16; ++r) S[db][r] *= dec64;
#pragma unroll
                for (int t = 0; t < 4; ++t) {
                    const bf16x8 ka8 = *(const LAS bf16x8*)(lds + RT_KT + (32 * db + l31) * RT_TROW + t * 32 + hi * 16);
                    const bf16x8 vb8 = *(const LAS bf16x8*)(lds + RT_VT + (32 * eb + l31) * RT_TROW + t * 32 + hi * 16);
                    S[db] = mfma32(ka8, vb8, S[db]);
                }
            }
        }
        if (n >= 1) {
            float t1 = 0.f, t2 = 0.f;
#pragma unroll
            for (int r = 0; r < 16; ++r) { t1 += o[r]; t2 += o[r] * o[r]; }
            t1 += __shfl_xor(t1, 32); t2 += __shfl_xor(t2, 32);
            if (hi == 0) *(LAS f32x2*)(lds + RT_ST + ((ib * 4 + eb) * 32 + l31) * 8) = (f32x2){t1, t2};
        }
        asm volatile("s_waitcnt lgkmcnt(0)" ::: "memory"); __builtin_amdgcn_s_barrier(); asm volatile("" ::: "memory");
        if (n >= 1) {
            float t1 = 0.f, t2 = 0.f;
#pragma unroll
            for (int e4 = 0; e4 < 4; ++e4) { const f32x2 p = *(const LAS f32x2*)(lds + RT_ST + ((ib * 4 + e4) * 32 + l31) * 8); t1 += p.x; t2 += p.y; }
            const float mu = t1 * (1.f / 128.f), var = t2 * (1.f / 128.f) - mu * mu, rs = rsqrtf(fmaxf(var, 0.f) + EPSN);
            const size_t rowq = (size_t)b * SEQ + 64 * (n - 1) + 32 * ib + l31;
#pragma unroll
            for (int g4 = 0; g4 < 4; ++g4) {
                const int e0 = h * 128 + 32 * eb + 8 * g4 + 4 * hi;
                const f32x4 gv = gnv[g4]; const v2u gr = grv[g4];
                const float g0 = bf2f((unsigned short)(gr.x & 0xffffu)), g1 = bf2f((unsigned short)(gr.x >> 16)), g2 = bf2f((unsigned short)(gr.y & 0xffffu)), g3 = bf2f((unsigned short)(gr.y >> 16));
#define RT_SILU(g) ((g) * __builtin_amdgcn_rcpf(1.f + ex2((g) * -1.4426950408889634f)))
                const float y0 = (o[4 * g4] - mu) * rs * gv.x * RT_SILU(g0), y1 = (o[4 * g4 + 1] - mu) * rs * gv.y * RT_SILU(g1);
                const float y2 = (o[4 * g4 + 2] - mu) * rs * gv.z * RT_SILU(g2), y3 = (o[4 * g4 + 3] - mu) * rs * gv.w * RT_SILU(g3);
#undef RT_SILU
                *(v2u*)(A2 + rowq * 2048 + 1024 + e0) = (v2u){cvtpk(y0, y1), cvtpk(y2, y3)};
            }
        }
    }
#undef RT_LOAD
}

#define XB_TMO      128
#define XB_XCNT(j)  (256  + 64 * (j))
#define XB_XSUB(j)  (1280 + 64 * (j))
#define XB_XGEN(j)  (2304 + 64 * (j))
#define XB_TOP      3328
#define XB_TOPGEN   3392
#define XCD_BAR_WORDS 3456
#define XB_SPIN_CAP (1u << 22)

__device__ __forceinline__ unsigned xb_ld(unsigned* p)              { return __hip_atomic_load(p, __ATOMIC_RELAXED, __HIP_MEMORY_SCOPE_AGENT); }
__device__ __forceinline__ unsigned xb_add(unsigned* p, unsigned v) { return __hip_atomic_fetch_add(p, v, __ATOMIC_RELAXED, __HIP_MEMORY_SCOPE_AGENT); }
__device__ __forceinline__ unsigned xb_xcc_id() { return (unsigned)__builtin_amdgcn_s_getreg((3 << 11) | 20) & 0xFu; }
#define XB_SPIN(cond, bar) do { unsigned _sp = 0; while (cond) { __builtin_amdgcn_s_sleep(1); \
    if ((++_sp & 255u) == 0u) { if (xb_ld(&(bar)[XB_TMO])) break; if (_sp > XB_SPIN_CAP) { atomicAdd(&(bar)[XB_TMO], 1u); break; } } } } while (0)

struct XcdBarrier {
    unsigned* bar; unsigned x;
    volatile LAS unsigned* st;
};

__device__ __forceinline__ XcdBarrier xcd_barrier_post(unsigned* bar, volatile LAS unsigned* st) {
    XcdBarrier b; b.bar = bar; b.x = xb_xcc_id(); b.st = st;
    if (threadIdx.x == 0) (void)xb_add(&bar[XB_XCNT(b.x)], 1u);
    return b;
}
__device__ __forceinline__ void xcd_barrier_complete(unsigned* bar, unsigned x, unsigned& nloc, unsigned& nx) {
    const unsigned G = gridDim.x * gridDim.y * gridDim.z;
    unsigned sum, cnt, mine, sp = 0u;
    for (;;) {
        sum = 0u; cnt = 0u; mine = 0u;
#pragma unroll
        for (unsigned j = 0; j < 16; ++j) { const unsigned c = xb_ld(&bar[XB_XCNT(j)]); sum += c; cnt += (c > 0u) ? 1u : 0u; mine = (j == x) ? c : mine; }
        if (sum == G) break;
        __builtin_amdgcn_s_sleep(1);
        if ((++sp & 255u) == 0u) { if (xb_ld(&bar[XB_TMO])) break; if (sp > XB_SPIN_CAP) { atomicAdd(&bar[XB_TMO], 1u); break; } }
    }
    nloc = mine > 0u ? mine : 1u; nx = cnt > 0u ? cnt : 1u;
}

__device__ __forceinline__ void xcd_barrier(const XcdBarrier& b) {
    asm volatile("s_waitcnt vmcnt(0)" ::: "memory");
    __syncthreads();
    if (threadIdx.x == 0) {
        unsigned* bar = b.bar;
        __builtin_amdgcn_s_waitcnt(0);
        unsigned nloc = b.st[0], nx = b.st[1];
        if (nloc == 0u) { xcd_barrier_complete(bar, b.x, nloc, nx); b.st[0] = nloc; b.st[1] = nx; }
        const unsigned old = xb_add(&bar[XB_XSUB(b.x)], 1u);
        const unsigned gen = old / nloc;
        if (old + 1u == (gen + 1u) * nloc) {
            __builtin_amdgcn_fence(__ATOMIC_RELEASE, "agent");
            asm volatile("s_waitcnt vmcnt(0)" ::: "memory");
            const unsigned og = xb_add(&bar[XB_TOP], 1u);
            const unsigned tg = og / nx;
            if (og + 1u == (tg + 1u) * nx) xb_add(&bar[XB_TOPGEN], 1u);
            else XB_SPIN(xb_ld(&bar[XB_TOPGEN]) == tg, bar);
            __builtin_amdgcn_fence(__ATOMIC_ACQUIRE, "agent");
            xb_add(&bar[XB_XGEN(b.x)], 1u);
            asm volatile("s_waitcnt vmcnt(0)" ::: "memory");
        } else {
            XB_SPIN(xb_ld(&bar[XB_XGEN(b.x)]) == gen, bar);
            __builtin_amdgcn_fence(__ATOMIC_ACQUIRE, "agent");
            asm volatile("s_waitcnt vmcnt(0)" ::: "memory");
        }
    }
    __syncthreads();
}

struct Args { const float* in[16]; float* out; unsigned char* ws; int ph_lo, ph_hi, dummy, pad; };
constexpr size_t WS_DUMMY = 906 * MiB;
#ifndef PROBE_SEQ
#define PROBE_SEQ 0, 1, 2, 3, 4, 5, 6
#endif
constexpr int NPHASE = 7;
constexpr size_t WS_SSFIN = 904 * MiB, WS_CNT = 905 * MiB, WS_BAR = 905 * MiB + 512 * 1024;
__global__ void __launch_bounds__(512, 2) hymba_fwd(Args args) {
    extern __shared__ __attribute__((aligned(16))) unsigned char lds_raw[];
    LAS unsigned char* lds = (LAS unsigned char*)lds_raw;
    cg::grid_group grid = cg::this_grid();
    typedef const __attribute__((address_space(4))) Args* ArgsCP;
    ArgsCP ap_ = (ArgsCP)__builtin_amdgcn_kernarg_segment_ptr();
#define PHASE_BEGIN() ArgsCP ap = ap_; asm volatile("" : "+s"(ap)); unsigned char* ws = ap->ws; asm volatile("" : "+s"(ws)); int tid = threadIdx.x; asm volatile("" : "+v"(tid)); \
    const int lane = tid & 63, wave = __builtin_amdgcn_readfirstlane(tid >> 6); const int G = gridDim.x, bx = blockIdx.x; \
    const int gw = bx * 8 + wave, ngw = G * 8, gtid = bx * 512 + tid, ngt = G * 512; (void)lane; (void)wave; (void)gw; (void)ngw; (void)gtid; (void)ngt; (void)ws
#define INP(i) (ap->in[i])
#define WSB(off) ((bf16*)(ws + (off)))
#define WSU(off) ((u64*)(ws + (off)))
    const int lo = args.ph_lo, hi = args.ph_hi;
#define IN(k) (lo <= (k) && (k) < hi)
#define SEAM(k) do { if (IN(k) && IN((k) + 1)) xcd_barrier(xbar); } while (0)
    if (threadIdx.x < 16) ((LAS unsigned*)(lds + LDS_BYTES - 64))[threadIdx.x] = 0u;
    __syncthreads();
    if (ap_->ph_hi > 64) grid.sync();
    XcdBarrier xbar; xbar.bar = nullptr; xbar.x = 0; xbar.st = nullptr;
    if (hi - lo > 1) xbar = xcd_barrier_post((unsigned*)(ap_->ws + WS_BAR), (volatile LAS unsigned*)(lds + LDS_BYTES - 64));

    if (IN(0)) {
        PHASE_BEGIN();
        const float* x = INP(0); const float* meta = INP(1); const float* g_mix = INP(2); const float* w_in = INP(3);
        u64* SSQ = WSU(WS_SSQ); u64* SSKV = WSU(WS_SSKV); u64* SSMLA = WSU(WS_SSMLA); u64* SSH1 = WSU(WS_SSH1); f32x2* ROPE = (f32x2*)(ws + WS_ROPE);
        bf16* RK = WSB(WS_RK); bf16* RV = WSB(WS_RV); bf16* CKV = WSB(WS_CKV); bf16* KRAW = WSB(WS_KRAW); bf16* XN = WSB(WS_XN);
        LAS float* scr = (LAS float*)(lds + wave * 16640);
        constexpr int I1 = 32 * 80, I2 = 8 * 24, I3 = 4 * 16, I4 = 4 * 16, I5 = 32 * 32, I6 = 32 * 128, I7 = 128 * 32;
        constexpr int NITEMS = I1 + I2 + I3 + I4 + I6 / 2; (void)I5; (void)I7;
        constexpr float QSCALE = 0.07216878364870323f * 1.4426950408889634f;
        const int pf = ap->dummy;
        if (!(pf & 2))
        for (int it = gw; it < NITEMS; it += ngw) {
            int r = it;
            if (r < I1) { p0_transpose_item(w_in, 2048, NINV, 0, nullptr, 0, 1.f, WSB(WS_WIN), scr, r / 80, r % 80, lane); continue; } r -= I1;
            if (r < I2) { p0_transpose_item(INP(6), 512, 1536, 0, INP(5), 512, QSCALE, WSB(WS_WUQ), scr, r / 24, r % 24, lane); continue; } r -= I2;
            if (r < I3) { p0_transpose_item(INP(8), 256, 1024, 0, INP(7), 256, 1.f, WSB(WS_WUK), scr, r / 16, r % 16, lane); continue; } r -= I3;
            if (r < I4) { p0_transpose_item(INP(9), 256, 1024, 0, INP(7), 256, 1.f, WSB(WS_WUV), scr, r / 16, r % 16, lane); continue; } r -= I4;
            p0_transpose_item(INP(13), 2048, 8192, 0, INP(12), 2048, 1.f, WSB(WS_WUP), scr, r / 128, r % 128, lane);
        }
        if (!(pf & 4))
        {
            const int nx = (G > 68 ? G - 34 : G) * 8;
            if (gw < nx) for (int m = 2 * gw; m < MROWS; m += 2 * nx) rms_rows2_to_bf16(x + (size_t)m * DM, x + (size_t)(m + 1) * DM, g_mix, XN + (size_t)m * DM, XN + (size_t)(m + 1) * DM, lane);
        }
        if (!(pf & 8)) {
        for (int i = gtid; i < NPOS * 64; i += ngt) {
            const int pos = i >> 6, f = i & 63;
            const float inv = 1.0f / powf(10000.0f, (float)(2 * f) / 128.0f);
            const float ang = (float)pos * inv;
            ROPE[i] = (f32x2){cosf(ang), sinf(ang)};
        }
        for (int i = gtid; i < MROWS; i += ngt) { SSQ[i] = 0ull; SSMLA[i] = 0ull; SSH1[i] = 0ull; WSU(WS_SSFIN)[i] = 0ull; }
        for (int i = gtid; i < 128 * 64; i += ngt) ((unsigned*)(ws + WS_CNT))[i] = 0u;
        for (int i = gtid; i < MPAD; i += ngt) { const int p = i % LP; if (p < 48 || p >= 64) SSKV[i] = 0ull; }
        const v4u z4 = (v4u){0u, 0u, 0u, 0u};
        for (int i = gtid; i < NB * 48 * 128; i += ngt) { const int row = i >> 7, pc = i & 127; const size_t rp = (size_t)(row / 48) * LP + (row % 48); *(v4u*)(RK + rp * 1024 + pc * 8) = z4; *(v4u*)(RV + rp * 1024 + pc * 8) = z4; }
        for (int i = gtid; i < NB * 48 * 32; i += ngt) { const int row = i >> 5, pc = i & 31; const size_t rp = (size_t)(row / 48) * LP + (row % 48); *(v4u*)(CKV + rp * 256 + pc * 8) = z4; }
        for (int i = gtid; i < NB * 48 * 8; i += ngt) { const int row = i >> 3, pc = i & 7; const size_t rp = (size_t)(row / 48) * LP + (row % 48); *(v4u*)(KRAW + rp * 64 + pc * 8) = z4; }
        const int mi = G - 1 - bx;
        if (mi < 34) {
            __syncthreads();
            if (mi < 16)       p0_meta_item<1>(meta, g_mix, w_in, 1024 + 64 * mi, 64, RK, 1024, 64 * mi, nullptr, lds, wave, lane);
            else if (mi < 32)  p0_meta_item<1>(meta, g_mix, w_in, 2048 + 64 * (mi - 16), 64, RV, 1024, 64 * (mi - 16), nullptr, lds, wave, lane);
            else if (mi == 32) p0_meta_item<1>(meta, g_mix, w_in, 4864, 64, KRAW, 64, 0, nullptr, lds, wave, lane);
            else               p0_meta_item<4>(meta, g_mix, w_in, 4608, 256, CKV, 256, 0, SSKV, lds, wave, lane);
        }
        }
    }
    SEAM(0);
    if (IN(1)) {
        PHASE_BEGIN();
        pg8::Gemm g{WSB(WS_XN), WSB(WS_WIN), MROWS, NIN, DM}; pg8::StaticOrder S; S.init(MROWS, NIN, G, bx);
        pg8::EpiInProj E{WSB(WS_RQ), WSB(WS_RK), WSB(WS_RV), WSB(WS_RG), WSB(WS_CQ), WSB(WS_CKV), WSB(WS_KRAW), ap->dummy ? WSU(WS_DUMMY) : WSU(WS_SSQ), ap->dummy ? WSU(WS_DUMMY + MiB) : WSU(WS_SSKV)};
        pg8::gemm_phase<pg8::EpiInProj, pg8::StaticOrder, true, true>(lds, g, S, E);
    }
    SEAM(1);
    if (IN(2)) {
        PHASE_BEGIN();
        const bf16* KRAW = WSB(WS_KRAW); bf16* KR2 = WSB(WS_KR2); const f32x2* ROPE = (const f32x2*)(ws + WS_ROPE);
        for (int i = gtid; i < MPAD * 32; i += ngt) {
            const int rp = i >> 5, t = i & 31, p = rp % LP; const int pos = p < 48 ? 0 : p - 48;
            const float x1 = bf2f(KRAW[(size_t)rp * 64 + t]), x2 = bf2f(KRAW[(size_t)rp * 64 + 32 + t]); const f32x2 cs = ROPE[pos * 64 + 2 * t];
            KR2[(size_t)rp * 64 + t] = (bf16)f2bf(x1 * cs.x - x2 * cs.y); KR2[(size_t)rp * 64 + 32 + t] = (bf16)f2bf(x1 * cs.y + x2 * cs.x);
        }
#if NAIVE_RET
        ret_naive(WSB(WS_RQ), WSB(WS_RK), WSB(WS_RV), WSB(WS_RG), ROPE, INP(4), WSB(WS_A2), gw, ngw, lane);
        const int GG = G, gc = bx; const bool do_gemm = true;
#else
        const int nret = G >= 256 ? 128 : G / 2;
        if (bx < nret && !(ap->dummy & 16)) { for (int it = bx; it < NB * 8; it += nret) ret_unit(lds, WSB(WS_RQ), WSB(WS_RK), WSB(WS_RV), WSB(WS_RG), ROPE, INP(4), WSB(WS_A2), it >> 3, it & 7, tid); }
        const int GG = G - nret, gc = bx - nret; const bool do_gemm = bx >= nret && !(ap->dummy & 32);
#endif
        if (do_gemm) {
            { pg8::Gemm g{WSB(WS_CQ), WSB(WS_WUQ), MROWS, 1536, 512}; pg8::StaticOrder S; S.init(MROWS, 1536, GG, gc);
              pg8::EpiRowScale E{WSB(WS_Q), 1536, WSU(WS_SSQ), 1.0f / (FIXS * 512.0f)};
              pg8::gemm_phase<pg8::EpiRowScale, pg8::StaticOrder, true, true>(lds, g, S, E); }
            { pg8::Gemm g{WSB(WS_CKV), WSB(WS_WUK), MPAD, 1024, 256}; pg8::StaticOrder S; S.init(MPAD, 1024, GG, gc);
              pg8::EpiRowScale E{WSB(WS_KN), 1024, WSU(WS_SSKV), 1.0f / (FIXS * 256.0f)};
              pg8::gemm_phase<pg8::EpiRowScale, pg8::StaticOrder, true, true>(lds, g, S, E); }
            { pg8::Gemm g{WSB(WS_WUV), WSB(WS_CKV), 1024, MPAD, 256}; pg8::StaticOrder S; S.init(1024, MPAD, GG, gc);
              pg8::EpiColScale E{WSB(WS_VT), MPAD, WSU(WS_SSKV), 1.0f / (FIXS * 256.0f)};
              pg8::gemm_phase<pg8::EpiColScale, pg8::StaticOrder, true, true>(lds, g, S, E); }
            { LAS float* scr = (LAS float*)(lds + wave * 16640); constexpr int J5 = 32 * 32, J6 = 32 * 128, J7 = 128 * 32;
              for (int it = gc * 8 + wave; it < J5 + J7 + J6 / 2; it += GG * 8) {
                  int r = it;
                  if (r >= J5 + J7) { r -= J5 + J7; p0_transpose_item(INP(13), 2048, 8192, 0, INP(12), 2048, 1.f, WSB(WS_WUP), scr, 16 + r / 128, r % 128, lane); continue; }
                  if (r < J5) { p0_transpose_item(INP(11), 2048, 2048, 1024, INP(10), 1024, 1.f, WSB(WS_WO), scr, r / 32, r % 32, lane); continue; } r -= J5;
                  p0_transpose_item(INP(14), 8192, 2048, 0, nullptr, 0, 1.f, WSB(WS_WDN), scr, r / 32, r % 32, lane);
              } }
        }
    }
    SEAM(2);
    if (IN(3)) {
        PHASE_BEGIN();
#if NAIVE_MLA
        mla_naive(WSB(WS_Q), WSB(WS_KN), WSB(WS_KR2), WSB(WS_VT), (const f32x2*)(ws + WS_ROPE), WSB(WS_A2), WSU(WS_SSMLA), gw, ngw, lane);
#else
        const int vcu = (G % 8 == 0) ? (bx % 8) * (G / 8) + bx / 8 : bx;
        for (int c = vcu; c < 256; c += G) {
            const int b = c >> 4, h = (c >> 1) & 7; const unsigned tbl = (c & 1) ? 0x1346u : 0x0257u;
#pragma unroll 1
            for (int j = 0; j < 4; ++j) mla_unit(lds, WSB(WS_Q), WSB(WS_KN), WSB(WS_KR2), WSB(WS_VT), (const f32x2*)(ws + WS_ROPE), WSB(WS_A2), ap->dummy ? WSU(WS_DUMMY) : WSU(WS_SSMLA), b, h, (int)((tbl >> (4 * j)) & 15u), tid);
        }
#endif
    }
    SEAM(3);
    if (IN(4)) {
        PHASE_BEGIN();
        pg8::Gemm g{WSB(WS_A2), WSB(WS_WO), MROWS, DM, DM}; pg8::StaticOrder S; S.init(MROWS, DM, G, bx);
        pg8::EpiWo E{INP(0), ap->out, WSB(WS_XN), ap->dummy ? WSU(WS_DUMMY) : WSU(WS_SSH1), WSU(WS_SSMLA)};
        pg8::gemm_phase<pg8::EpiWo, pg8::StaticOrder, true, true>(lds, g, S, E);
    }
    SEAM(4);
    if (IN(5)) {
        PHASE_BEGIN();
        pg8::Gemm g{WSB(WS_XN), WSB(WS_WUP), MROWS, FFN, DM}; pg8::StaticOrder S; S.init(MROWS, FFN, G, bx);
        pg8::EpiUp E{WSB(WS_HID), WSU(WS_SSH1)};
        pg8::gemm_phase<pg8::EpiUp, pg8::StaticOrder, true, true>(lds, g, S, E);
    }
    SEAM(5);
    if (IN(6)) {
        PHASE_BEGIN();
        const int vcu = (G % 8 == 0) ? (bx % 8) * (G / 8) + bx / 8 : bx;
        pg8::Gemm g{WSB(WS_HID), WSB(WS_WDN), MROWS, DM, FFN}; pg8::PanelOrder S{G, vcu};
        pg8::EpiDownNorm E{ap->out, WSB(WS_XN), INP(15), WSU(WS_SSFIN), (unsigned*)(ws + WS_CNT)};
        pg8::gemm_phase<pg8::EpiDownNorm, pg8::PanelOrder, true, true>(lds, g, S, E);
    }
#undef IN
#undef SEAM
}

extern "C" void kernel_launch(void* const* d_in, const int* in_sizes, int n_in, void* d_out, int out_size, void* d_ws, size_t ws_size, hipStream_t stream) {
    static int grid = 0;
    if (grid == 0) {
        if (n_in != 16 || in_sizes[0] != MROWS * DM || out_size != MROWS * DM || ws_size < 908 * MiB) { fprintf(stderr, "kernel_launch: unexpected problem geometry (n_in %d, ws %zu)\n", n_in, ws_size); grid = -1; return; }
        int dev = 0, cus = 0, per_cu = 0;
        (void)hipGetDevice(&dev); (void)hipDeviceGetAttribute(&cus, hipDeviceAttributeMultiprocessorCount, dev);
        if (hipFuncSetAttribute((const void*)hymba_fwd, hipFuncAttributeMaxDynamicSharedMemorySize, LDS_BYTES) != hipSuccess) { fprintf(stderr, "kernel_launch: hipFuncSetAttribute failed\n"); grid = -1; return; }
        if (hipOccupancyMaxActiveBlocksPerMultiprocessor(&per_cu, (const void*)hymba_fwd, 512, LDS_BYTES) != hipSuccess || per_cu < 1) per_cu = 1;
        (void)hipGetLastError();
        grid = cus * per_cu;
        if (grid <= 0) grid = 256;
    }
    if (grid < 0) return;
    Args a{};
    for (int i = 0; i < 16; ++i) a.in[i] = (const float*)d_in[i];
    a.out = (float*)d_out; a.ws = (unsigned char*)d_ws;
#if ONE_LAUNCH
    (void)hipMemsetAsync((unsigned char*)d_ws + WS_BAR, 0, XCD_BAR_WORDS * 4, stream);
    a.ph_lo = 0; a.ph_hi = NPHASE;
    void* kargs[] = {&a};
    hipError_t e = hipLaunchCooperativeKernel((const void*)hymba_fwd, dim3(grid), dim3(512), kargs, LDS_BYTES, stream);
    if (e != hipSuccess) fprintf(stderr, "cooperative launch failed: %s (grid %d)\n", hipGetErrorString(e), grid);
#else
    static const int seq[] = {PROBE_SEQ};
    for (unsigned i = 0; i < sizeof(seq) / sizeof(seq[0]); ++i) { a.ph_lo = seq[i] & 15; a.ph_hi = a.ph_lo + 1; a.dummy = seq[i] >> 4; hipLaunchKernelGGL(hymba_fwd, dim3(grid), dim3(512), LDS_BYTES, stream, a); }
#endif
}
```

```cpp
#include <hip/hip_runtime.h>
#include <hip/hip_cooperative_groups.h>
#include <cstdio>
#include <cstdint>
namespace cg = cooperative_groups;
#ifndef ONE_LAUNCH
#define ONE_LAUNCH 1
#endif
#ifndef NAIVE_RET
#define NAIVE_RET 0
#endif
#ifndef NAIVE_MLA
#define NAIVE_MLA 0
#endif
typedef unsigned long long u64;
namespace pg8 {
#define PG8_LAS __attribute__((address_space(3)))
typedef unsigned short bf16_t;
typedef short bf16x8 __attribute__((ext_vector_type(8)));
typedef float f32x4 __attribute__((ext_vector_type(4)));
typedef unsigned u32x4 __attribute__((ext_vector_type(4)));
constexpr int BM = 256, BK = 64, HALF = 128, HTB = HALF * BK * 2  , STAGE_BYTES = 8 * HTB, NXCD = 8, WGM = 8;

__host__ __device__ __forceinline__ int lds_byte(int r, int c) { const int st = (r >> 4) * 2 + (c >> 5), rr = r & 15, cc = c & 31, ob = rr * 64 + cc * 2; return st * 1024 + (ob ^ (((ob >> 9) & 1) << 5)); }
__host__ __device__ __forceinline__ void stage_rc(int b, int& R, int& C) { const int st = b / 1024, sb = b % 1024, swz = sb ^ (((sb >> 9) & 1) << 5); R = (st >> 1) * 16 + swz / 64; C = (st & 1) * 32 + (swz % 64) / 2; }
__host__ __device__ __forceinline__ int perm32(int rho) { const int n = rho >> 4, i = rho & 15; return 8 * (i >> 2) + 4 * n + (i & 3); }

struct Unit { int pm, pn; };
struct Gemm { const bf16_t* A; const bf16_t* Bt; int M, N, K; };

struct StaticOrder {
    int nM, nN, nwg, G, c;
    __host__ __device__ void init(int M, int N, int G_, int c_) { nM = M / BM; nN = N / BM; nwg = nM * nN; G = G_; c = c_; }
    __host__ __device__ bool next(int i, Unit& u) const {
        const long L = (long)i * G + c; if (L >= nwg) return false;
        int wgid = (int)L; { const int q = nwg / NXCD, r = nwg % NXCD, xcd = wgid % NXCD, off = wgid / NXCD; wgid = (xcd < r ? xcd * (q + 1) : r * (q + 1) + (xcd - r) * q) + off; }
        const int nig = WGM * nN, gid = wgid / nig, fm = gid * WGM, gsz = (nM - fm) < WGM ? (nM - fm) : WGM;
        u.pm = fm + ((wgid % nig) % gsz); u.pn = (wgid % nig) / gsz; return true;
    }
    __device__ __forceinline__ void a_ready(const Unit&) const {}
    __device__ __forceinline__ void done(const Unit&) const {}
};

__device__ __forceinline__ unsigned cvt_pk_bf16(float lo, float hi) { unsigned r; asm volatile("v_cvt_pk_bf16_f32 %0, %1, %2" : "=v"(r) : "v"(lo), "v"(hi)); return r; }
typedef unsigned u32x2 __attribute__((ext_vector_type(2)));
constexpr float FIXS = 16777216.0f;
__device__ __forceinline__ float sq4(const f32x4 v) { return (v[0] * v[0] + v[1] * v[1]) + (v[2] * v[2] + v[3] * v[3]); }
__device__ __forceinline__ u32x4 pack8(const f32x4 v0, const f32x4 v1) { u32x4 w; w.x = cvt_pk_bf16(v0[0], v0[1]); w.y = cvt_pk_bf16(v0[2], v0[3]); w.z = cvt_pk_bf16(v1[0], v1[1]); w.w = cvt_pk_bf16(v1[2], v1[3]); return w; }

struct EpiInProj {
    static constexpr bool PERM = true, AFTER_DRAIN = false, MIDK = false;
    bf16_t *RQ, *RK, *RV, *RG, *CQ, *CKV, *KR; u64 *SSQ, *SSKV;
    __device__ __forceinline__ void midk(f32x4 (&)[2][2][4][2], const Unit&, int, int) const {}
    __device__ __forceinline__ void operator()(const f32x4 (&acc)[2][2][4][2], const Unit& u, int wr, int wc, int fr, int fq) const {
        const int pn = u.pn, b = u.pm >> 3;
        bf16_t* base; int ld, c0; bool padded; u64* ss = nullptr;
        if (pn < 4)        { base = RQ;  ld = 1024; c0 = 256 * pn;        padded = false; }
        else if (pn < 8)   { base = RK;  ld = 1024; c0 = 256 * (pn - 4);  padded = true; }
        else if (pn < 12)  { base = RV;  ld = 1024; c0 = 256 * (pn - 8);  padded = true; }
        else if (pn < 16)  { base = RG;  ld = 1024; c0 = 256 * (pn - 12); padded = false; }
        else if (pn < 18)  { base = CQ;  ld = 512;  c0 = 256 * (pn - 16); padded = false; ss = SSQ; }
        else if (pn == 18) { base = CKV; ld = 256;  c0 = 0;               padded = true;  ss = SSKV; }
        else               { base = KR;  ld = 64;   c0 = 0;               padded = true; }
        const int row0 = u.pm * BM + wr * 64 + fr + (padded ? 64 * (b + 1) : 0);
        const int ct = wc * 32 + 8 * fq;
        const bool full = pn < 19;
#pragma unroll
        for (int ai = 0; ai < 2; ++ai)
#pragma unroll
            for (int m = 0; m < 4; ++m) {
                const int r = row0 + ai * HALF + m * 16;
                bf16_t* rowp = base + (size_t)r * ld + c0 + ct;
                float s = 0.f;
#pragma unroll
                for (int bj = 0; bj < 2; ++bj) {
                    const f32x4 v0 = acc[ai][bj][m][0], v1 = acc[ai][bj][m][1];
                    s += sq4(v0) + sq4(v1);
                    if (full || (bj == 0 && wc < 2)) *(u32x4*)(rowp + bj * HALF) = pack8(v0, v1);
                }
                if (ss) { s += __shfl_xor(s, 16); s += __shfl_xor(s, 32); if (fq == 0) atomicAdd(ss + r, (u64)(s * FIXS)); }
            }
    }
};
struct EpiRowScale {
    static constexpr bool PERM = true, AFTER_DRAIN = false, MIDK = false;
    bf16_t* O; int ld; const u64* ss; float inv;
    __device__ __forceinline__ void midk(f32x4 (&)[2][2][4][2], const Unit&, int, int) const {}
    __device__ __forceinline__ void operator()(const f32x4 (&acc)[2][2][4][2], const Unit& u, int wr, int wc, int fr, int fq) const {
        const int row0 = u.pm * BM + wr * 64 + fr, col0 = u.pn * BM + wc * 32 + 8 * fq;
#pragma unroll
        for (int ai = 0; ai < 2; ++ai)
#pragma unroll
            for (int m = 0; m < 4; ++m) {
                const int r = row0 + ai * HALF + m * 16;
                const float sc = rsqrtf((float)ss[r] * inv + 1e-6f);
                bf16_t* rowp = O + (size_t)r * ld + col0;
#pragma unroll
                for (int bj = 0; bj < 2; ++bj) *(u32x4*)(rowp + bj * HALF) = pack8(acc[ai][bj][m][0] * sc, acc[ai][bj][m][1] * sc);
            }
    }
};
struct EpiColScale {
    static constexpr bool PERM = true, AFTER_DRAIN = false, MIDK = false;
    bf16_t* O; int ld; const u64* ss; float inv;
    __device__ __forceinline__ void midk(f32x4 (&)[2][2][4][2], const Unit&, int, int) const {}
    __device__ __forceinline__ void operator()(const f32x4 (&acc)[2][2][4][2], const Unit& u, int wr, int wc, int fr, int fq) const {
        const int row0 = u.pm * BM + wr * 64 + fr, col0 = u.pn * BM + wc * 32 + 8 * fq;
        f32x4 sc[2][2];
#pragma unroll
        for (int bj = 0; bj < 2; ++bj)
#pragma unroll
            for (int n = 0; n < 2; ++n)
#pragma unroll
                for (int j = 0; j < 4; ++j) sc[bj][n][j] = rsqrtf((float)ss[col0 + bj * HALF + 4 * n + j] * inv + 1e-6f);
#pragma unroll
        for (int ai = 0; ai < 2; ++ai)
#pragma unroll
            for (int m = 0; m < 4; ++m) {
                const int r = row0 + ai * HALF + m * 16;
                bf16_t* rowp = O + (size_t)r * ld + col0;
#pragma unroll
                for (int bj = 0; bj < 2; ++bj) *(u32x4*)(rowp + bj * HALF) = pack8(acc[ai][bj][m][0] * sc[bj][0], acc[ai][bj][m][1] * sc[bj][1]);
            }
    }
};
struct EpiWo {
    static constexpr bool PERM = false, AFTER_DRAIN = false, MIDK = true;
    const float* x; float* out; bf16_t* xn2; u64* ssh1; const u64* ssmla;
    __device__ __forceinline__ void midk(f32x4 (&acc)[2][2][4][2], const Unit& u, int wr, int fr) const {
#pragma unroll
        for (int ai = 0; ai < 2; ++ai)
#pragma unroll
            for (int m = 0; m < 4; ++m) {
                const int r = u.pm * BM + ai * HALF + wr * 64 + m * 16 + fr;
                const float sc = rsqrtf((float)ssmla[r] * (1.0f / (FIXS * 1024.0f)) + 1e-6f);
#pragma unroll
                for (int bj = 0; bj < 2; ++bj)
#pragma unroll
                    for (int n = 0; n < 2; ++n) acc[ai][bj][m][n] = acc[ai][bj][m][n] * sc;
            }
    }
    __device__ __forceinline__ void operator()(const f32x4 (&acc)[2][2][4][2], const Unit& u, int wr, int wc, int fr, int fq) const {
        const int col0 = u.pn * BM + wc * 32 + 4 * fq;
#pragma unroll
        for (int ai = 0; ai < 2; ++ai)
#pragma unroll
            for (int m = 0; m < 4; ++m) {
                const int r = u.pm * BM + ai * HALF + wr * 64 + m * 16 + fr; const size_t off = (size_t)r * 2048 + col0;
                float s = 0.f;
#pragma unroll
                for (int bj = 0; bj < 2; ++bj)
#pragma unroll
                    for (int n = 0; n < 2; ++n) {
                        const f32x4 h = *(const f32x4*)(x + off + bj * HALF + n * 16) + acc[ai][bj][m][n];
                        u32x2 w; w.x = cvt_pk_bf16(h[0], h[1]); w.y = cvt_pk_bf16(h[2], h[3]);
                        *(u32x2*)(xn2 + off + bj * HALF + n * 16) = w;
                        s += sq4(h);
                    }
                s += __shfl_xor(s, 16); s += __shfl_xor(s, 32);
                if (fq == 0) atomicAdd(ssh1 + r, (u64)(s * FIXS));
            }
    }
};
struct EpiUp {
    static constexpr bool PERM = true, AFTER_DRAIN = false, MIDK = false;
    bf16_t* O; const u64* ss;
    __device__ __forceinline__ void midk(f32x4 (&)[2][2][4][2], const Unit&, int, int) const {}
    __device__ __forceinline__ void operator()(const f32x4 (&acc)[2][2][4][2], const Unit& u, int wr, int wc, int fr, int fq) const {
        const int row0 = u.pm * BM + wr * 64 + fr, col0 = u.pn * BM + wc * 32 + 8 * fq;
#pragma unroll
        for (int ai = 0; ai < 2; ++ai)
#pragma unroll
            for (int m = 0; m < 4; ++m) {
                const int r = row0 + ai * HALF + m * 16;
                const float sc = rsqrtf((float)ss[r] * (1.0f / (FIXS * 2048.0f)) + 1e-6f);
                bf16_t* rowp = O + (size_t)r * 8192 + col0;
#pragma unroll
                for (int bj = 0; bj < 2; ++bj) {
                    f32x4 v0 = acc[ai][bj][m][0] * sc, v1 = acc[ai][bj][m][1] * sc;
#pragma unroll
                    for (int j = 0; j < 4; ++j) { const float a = fmaxf(v0[j], 0.f), c = fmaxf(v1[j], 0.f); v0[j] = a * a; v1[j] = c * c; }
                    *(u32x4*)(rowp + bj * HALF) = pack8(v0, v1);
                }
            }
    }
};
struct PanelOrder {
    int G, v;
    __device__ __forceinline__ bool next(int i, Unit& u) const { const int L = i * G + v; if (L >= 1024) return false; u.pm = L >> 3; u.pn = L & 7; return true; }
    __device__ __forceinline__ void a_ready(const Unit&) const {}
    __device__ __forceinline__ void done(const Unit&) const {}
};
struct EpiDownNorm {
    static constexpr bool PERM = false, AFTER_DRAIN = false, MIDK = false;
    float* out; const bf16_t* h1b; const float* gfin; u64* ssfin; unsigned* cnt;
    __device__ __forceinline__ void midk(f32x4 (&)[2][2][4][2], const Unit&, int, int) const {}
    __device__ __forceinline__ void operator()(const f32x4 (&acc_c)[2][2][4][2], const Unit& u, int wr, int wc, int fr, int fq) const {
        f32x4 (&acc)[2][2][4][2] = const_cast<f32x4 (&)[2][2][4][2]>(acc_c);
        const int col0 = u.pn * BM + wc * 32 + 4 * fq;
        u64 chk = 0ull;
#pragma unroll
        for (int ai = 0; ai < 2; ++ai)
#pragma unroll
            for (int m = 0; m < 4; ++m) {
                const int r = u.pm * BM + ai * HALF + wr * 64 + m * 16 + fr; const size_t off = (size_t)r * 2048 + col0;
                float s = 0.f;
#pragma unroll
                for (int bj = 0; bj < 2; ++bj)
#pragma unroll
                    for (int n = 0; n < 2; ++n) { const u32x2 hb = *(const u32x2*)(h1b + off + bj * HALF + n * 16);
                        const f32x4 hres = (f32x4){__builtin_bit_cast(float, hb.x << 16), __builtin_bit_cast(float, hb.x & 0xffff0000u), __builtin_bit_cast(float, hb.y << 16), __builtin_bit_cast(float, hb.y & 0xffff0000u)};
                        const f32x4 h = hres + acc[ai][bj][m][n]; acc[ai][bj][m][n] = h; s += sq4(h); }
                s += __shfl_xor(s, 16); s += __shfl_xor(s, 32);
                if (fq == 0) chk ^= atomicAdd(ssfin + r, (u64)(s * FIXS));
            }
        asm volatile("s_waitcnt vmcnt(0)" : "+v"(chk) :: "memory");
        unsigned* c = cnt + 64 * u.pm;
        if (fr == 0 && fq == 0) {
            __hip_atomic_fetch_add(c, 1u, __ATOMIC_RELAXED, __HIP_MEMORY_SCOPE_AGENT);
            unsigned spins = 0;
            while (__hip_atomic_load(c, __ATOMIC_RELAXED, __HIP_MEMORY_SCOPE_AGENT) < 64u) { __builtin_amdgcn_s_sleep(2); if (++spins > (1u << 22)) break; }
        }
        asm volatile("" ::: "memory");
        f32x4 gv[2][2];
#pragma unroll
        for (int bj = 0; bj < 2; ++bj)
#pragma unroll
            for (int n = 0; n < 2; ++n) gv[bj][n] = *(const f32x4*)(gfin + col0 + bj * HALF + n * 16);
#pragma unroll
        for (int ai = 0; ai < 2; ++ai)
#pragma unroll
            for (int m = 0; m < 4; ++m) {
                const int r = u.pm * BM + ai * HALF + wr * 64 + m * 16 + fr; const size_t off = (size_t)r * 2048 + col0;
                const u64 sv = __hip_atomic_load(ssfin + r, __ATOMIC_RELAXED, __HIP_MEMORY_SCOPE_AGENT);
                const float sc = rsqrtf((float)sv * (1.0f / (FIXS * 2048.0f)) + 1e-6f);
#pragma unroll
                for (int bj = 0; bj < 2; ++bj)
#pragma unroll
                    for (int n = 0; n < 2; ++n) *(f32x4*)(out + off + bj * HALF + n * 16) = acc[ai][bj][m][n] * sc * gv[bj][n];
            }
    }
};

template <class Epi, class Sched, bool ALIGN_EPI = false, bool SP2 = false>
__device__ __forceinline__ void gemm_phase(PG8_LAS unsigned char* lds, const Gemm g, const Sched& S, const Epi& E) {
    const int tid = threadIdx.x, wid = __builtin_amdgcn_readfirstlane(tid >> 6), lane = tid & 63, wr = wid >> 2, wc = wid & 3, fr = lane & 15, fq = lane >> 4;
    const int K = g.K, nt = K / BK;
    unsigned voffA[2], voffB[2];
#pragma unroll
    for (int i = 0; i < 2; ++i) { int R, C; stage_rc(tid * 16 + i * 8192, R, C); const int Rb = Epi::PERM ? ((R & ~31) + perm32(R & 31)) : R;
        voffA[i] = (unsigned)(R * K + C) * 2u; voffB[i] = (unsigned)(Rb * K + C) * 2u; }
    const size_t kstep = (size_t)(BK * 2);
    const size_t hstep = (size_t)HALF * K * 2;
    const size_t tstep = 2 * hstep;
    const unsigned ldsw = (unsigned)wid * 1024u;
    const int aoff = lds_byte(wr * 64 + fr, fq * 8), boff = lds_byte(wc * 32 + fr, fq * 8);
#define PG8_SA(b, h) (((b) * 2 + (h)) * HTB)
#define PG8_SB(b, h) ((4 + (b) * 2 + (h)) * HTB)
#define PG8_STAGE(bufoff, gbase, voff) do { _Pragma("unroll") for (int _i = 0; _i < 2; ++_i) \
        __builtin_amdgcn_global_load_lds((const unsigned*)((const char*)(gbase) + (voff)[_i]), (PG8_LAS unsigned*)(lds + (bufoff) + ldsw + _i * 8192), 16, 0, 0); } while (0)
#define PG8_LDA(dst, b, h) do { _Pragma("unroll") for (int m = 0; m < 4; ++m) _Pragma("unroll") for (int k = 0; k < 2; ++k) dst[m][k] = *(const PG8_LAS bf16x8*)(lds + PG8_SA(b, h) + aoff + m * 2048 + k * 1024); } while (0)
#define PG8_LDB(dst, b, h) do { _Pragma("unroll") for (int n = 0; n < 2; ++n) _Pragma("unroll") for (int k = 0; k < 2; ++k) dst[n][k] = *(const PG8_LAS bf16x8*)(lds + PG8_SB(b, h) + boff + n * 2048 + k * 1024); } while (0)
#define PG8_MMA(ai, bj, At, Bt) do { __builtin_amdgcn_s_setprio(1); _Pragma("unroll") for (int m = 0; m < 4; ++m) _Pragma("unroll") for (int n = 0; n < 2; ++n) _Pragma("unroll") for (int k = 0; k < 2; ++k) \
        acc[ai][bj][m][n] = __builtin_amdgcn_mfma_f32_16x16x32_bf16(Bt[n][k], At[m][k], acc[ai][bj][m][n], 0, 0, 0); __builtin_amdgcn_s_setprio(0); } while (0)
#define PG8_WAIT_V(n) asm volatile("s_waitcnt vmcnt(" #n ")" ::: "memory")
#define PG8_WAIT_L(n) asm volatile("s_waitcnt lgkmcnt(" #n ")" ::: "memory")
#define PG8_BAR __builtin_amdgcn_s_barrier()
#define PG8_SCHED __builtin_amdgcn_sched_barrier(0)
    Unit cur, nxt; int ui = 0;
    if (!S.next(0, cur)) return;
    f32x4 acc[2][2][4][2];
#pragma unroll
    for (int a = 0; a < 2; ++a)
#pragma unroll
        for (int b = 0; b < 2; ++b)
#pragma unroll
            for (int m = 0; m < 4; ++m)
#pragma unroll
                for (int n = 0; n < 2; ++n) acc[a][b][m][n] = (f32x4){0.f, 0.f, 0.f, 0.f};
    bf16x8 At[4][2], B0[2][2], B1[2][2];
    const char* cA = (const char*)g.A + (size_t)cur.pm * tstep; const char* cB = (const char*)g.Bt + (size_t)cur.pn * tstep;
    S.a_ready(cur);
    if constexpr (SP2) {
        PG8_STAGE(PG8_SB(0, 0), cB, voffB); PG8_STAGE(PG8_SB(0, 1), cB + hstep, voffB); PG8_STAGE(PG8_SA(0, 0), cA, voffA); PG8_STAGE(PG8_SA(0, 1), cA + hstep, voffA);
        if (wr == 1) PG8_BAR;
        PG8_WAIT_V(2); PG8_BAR;
        PG8_STAGE(PG8_SB(1, 0), cB + kstep, voffB); PG8_STAGE(PG8_SA(1, 0), cA + kstep, voffA); PG8_STAGE(PG8_SB(1, 1), cB + hstep + kstep, voffB);
        PG8_WAIT_V(6); PG8_BAR;
    } else {
        PG8_STAGE(PG8_SB(0, 0), cB, voffB); PG8_STAGE(PG8_SA(0, 0), cA, voffA); PG8_STAGE(PG8_SB(0, 1), cB + hstep, voffB); PG8_STAGE(PG8_SA(0, 1), cA + hstep, voffA);
        if (wr == 1) PG8_BAR;
        PG8_WAIT_V(4); PG8_BAR;
        PG8_STAGE(PG8_SB(1, 0), cB + kstep, voffB); PG8_STAGE(PG8_SA(1, 0), cA + kstep, voffA); PG8_STAGE(PG8_SB(1, 1), cB + hstep + kstep, voffB);
        PG8_WAIT_V(6); PG8_BAR;
    }
    for (;;) {
        const bool has_next = S.next(ui + 1, nxt);
        const char* nA = has_next ? (const char*)g.A + (size_t)nxt.pm * tstep : cA; const char* nB = has_next ? (const char*)g.Bt + (size_t)nxt.pn * tstep : cB;
        for (int t = 0; t < nt; t += 2) {
            const bool last = (t == nt - 2);
            if constexpr (Epi::MIDK) { if (t == nt / 2) { const int l2 = (int)__builtin_amdgcn_mbcnt_hi(~0u, __builtin_amdgcn_mbcnt_lo(~0u, 0u)); E.midk(acc, cur, wr, l2 & 15); } }
            const char* a1 = cA + (size_t)(t + 1) * kstep;
            const char* a2 = last ? nA : cA + (size_t)(t + 2) * kstep; const char* b2 = last ? nB : cB + (size_t)(t + 2) * kstep;
            const char* a3 = a2 + kstep; const char* b3 = b2 + kstep;
            if (last && has_next) S.a_ready(nxt);
            if constexpr (SP2) {
            PG8_LDB(B0, 0, 0); PG8_LDB(B1, 0, 1); PG8_SCHED; PG8_LDA(At, 0, 0); PG8_STAGE(PG8_SA(1, 1), a1 + hstep, voffA);
            PG8_WAIT_V(8); PG8_WAIT_L(0); PG8_BAR; PG8_MMA(0, 0, At, B0); PG8_MMA(0, 1, At, B1); PG8_BAR; PG8_SCHED;
            PG8_LDA(At, 0, 1); PG8_STAGE(PG8_SB(0, 0), b2, voffB); PG8_STAGE(PG8_SB(0, 1), b2 + hstep, voffB); PG8_STAGE(PG8_SA(0, 0), a2, voffA);
            PG8_WAIT_V(8); PG8_WAIT_L(0); PG8_BAR; PG8_MMA(1, 0, At, B0); PG8_MMA(1, 1, At, B1); PG8_BAR; PG8_SCHED;
            PG8_LDB(B0, 1, 0); PG8_LDB(B1, 1, 1); PG8_SCHED; PG8_LDA(At, 1, 0); PG8_STAGE(PG8_SA(0, 1), a2 + hstep, voffA);
            PG8_WAIT_V(8); PG8_WAIT_L(0); PG8_BAR; PG8_MMA(0, 0, At, B0); PG8_MMA(0, 1, At, B1); PG8_BAR; PG8_SCHED;
            PG8_LDA(At, 1, 1); PG8_STAGE(PG8_SB(1, 0), b3, voffB); PG8_STAGE(PG8_SB(1, 1), b3 + hstep, voffB); PG8_STAGE(PG8_SA(1, 0), a3, voffA);
            PG8_WAIT_V(8); PG8_WAIT_L(0); PG8_BAR; PG8_MMA(1, 0, At, B0); PG8_MMA(1, 1, At, B1); PG8_BAR; PG8_SCHED;
            } else {
            PG8_LDB(B0, 0, 0); PG8_SCHED; PG8_LDA(At, 0, 0); PG8_STAGE(PG8_SA(1, 1), a1 + hstep, voffA);
            PG8_WAIT_L(8); PG8_BAR; PG8_WAIT_L(0); PG8_MMA(0, 0, At, B0); PG8_BAR; PG8_SCHED;
            PG8_LDB(B1, 0, 1); PG8_STAGE(PG8_SB(0, 0), b2, voffB);
            PG8_BAR; PG8_WAIT_L(0); PG8_MMA(0, 1, At, B1); PG8_BAR;
            PG8_LDA(At, 0, 1); PG8_STAGE(PG8_SA(0, 0), a2, voffA);
            PG8_BAR; PG8_WAIT_L(0); PG8_MMA(1, 0, At, B0); PG8_BAR; PG8_SCHED;
            PG8_STAGE(PG8_SB(0, 1), b2 + hstep, voffB);
            PG8_WAIT_V(6); PG8_BAR; PG8_MMA(1, 1, At, B1); PG8_BAR;
            PG8_LDB(B0, 1, 0); PG8_SCHED; PG8_LDA(At, 1, 0); PG8_STAGE(PG8_SA(0, 1), a2 + hstep, voffA);
            PG8_WAIT_L(8); PG8_BAR; PG8_WAIT_L(0); PG8_MMA(0, 0, At, B0); PG8_BAR; PG8_SCHED;
            PG8_LDB(B1, 1, 1); PG8_STAGE(PG8_SB(1, 0), b3, voffB);
            PG8_BAR; PG8_WAIT_L(0); PG8_MMA(0, 1, At, B1); PG8_BAR;
            PG8_LDA(At, 1, 1); PG8_STAGE(PG8_SA(1, 0), a3, voffA);
            PG8_BAR; PG8_WAIT_L(0); PG8_MMA(1, 0, At, B0); PG8_BAR; PG8_SCHED;
            PG8_STAGE(PG8_SB(1, 1), b3 + hstep, voffB);
            PG8_WAIT_V(6); PG8_BAR; PG8_MMA(1, 1, At, B1); PG8_BAR;
            }
        }
        if constexpr (ALIGN_EPI) { if (wr == 0) PG8_BAR; }
        if constexpr (!Epi::AFTER_DRAIN) { const int l2 = (int)__builtin_amdgcn_mbcnt_hi(~0u, __builtin_amdgcn_mbcnt_lo(~0u, 0u)); E(acc, cur, wr, wc, l2 & 15, l2 >> 4); S.done(cur); }
        if (!has_next) break;
#pragma unroll
        for (int a = 0; a < 2; ++a)
#pragma unroll
            for (int b = 0; b < 2; ++b)
#pragma unroll
                for (int m = 0; m < 4; ++m)
#pragma unroll
                    for (int n = 0; n < 2; ++n) acc[a][b][m][n] = (f32x4){0.f, 0.f, 0.f, 0.f};
        cur = nxt; cA = nA; cB = nB; ++ui;
        if constexpr (ALIGN_EPI) { if (wr == 1) PG8_BAR; }
    }
    PG8_WAIT_V(0);
    if constexpr (!ALIGN_EPI) { if (wr == 0) PG8_BAR; }
    PG8_BAR;
    if constexpr (Epi::AFTER_DRAIN) { E.fused(acc, cur, wr, wc, fr, fq, lds, wid, lane); S.done(cur); }
#undef PG8_SA
#undef PG8_SB
#undef PG8_STAGE
#undef PG8_LDA
#undef PG8_LDB
#undef PG8_MMA
#undef PG8_WAIT_V
#undef PG8_WAIT_L
#undef PG8_BAR
#undef PG8_SCHED
}
}

constexpr int NB = 16, SEQ = 2048, DM = 2048, LP = 2112, MROWS = NB * SEQ, MPAD = NB * LP, FFN = 8192;
constexpr int NIN = 5120, NINV = 4928;
constexpr int NPOS = 2064;
constexpr float EPSN = 1e-6f;
constexpr float FIXS = 16777216.0f;
constexpr size_t MiB = 1u << 20;
constexpr size_t WS_SSQ = 0, WS_SSKV = 512 * 1024, WS_SSMLA = 1 * MiB, WS_SSH1 = 1 * MiB + 512 * 1024;
constexpr size_t WS_ROPE = 2 * MiB;
constexpr size_t WS_WIN = 4 * MiB, WS_WUQ = 24 * MiB, WS_WUK = 26 * MiB, WS_WUV = 27 * MiB, WS_WO = 28 * MiB, WS_WUP = 36 * MiB, WS_WDN = 68 * MiB;
constexpr size_t WS_XN = 100 * MiB;
constexpr size_t WS_HID = 228 * MiB;
constexpr size_t WS_RQ = 228 * MiB, WS_RG = 292 * MiB, WS_RK = 356 * MiB, WS_RV = 422 * MiB, WS_CQ = 488 * MiB, WS_CKV = 520 * MiB, WS_KRAW = 537 * MiB, WS_KR2 = 542 * MiB;
constexpr size_t WS_Q = 547 * MiB, WS_KN = 643 * MiB, WS_VT = 709 * MiB, WS_A2 = 775 * MiB, WS_END = 903 * MiB;
static_assert(WS_HID + (size_t)MROWS * FFN * 2 <= WS_A2, "hid must not overlay A2");
constexpr int LDS_BYTES = 147456;
#define LAS __attribute__((address_space(3)))
typedef unsigned short bf16;
typedef unsigned v4u __attribute__((ext_vector_type(4)));
typedef unsigned v2u __attribute__((ext_vector_type(2)));
typedef float f32x4 __attribute__((ext_vector_type(4)));
typedef float f32x2 __attribute__((ext_vector_type(2)));
__device__ __forceinline__ unsigned f2bf(float f) { unsigned u = __builtin_bit_cast(unsigned, f); return (u + 0x7fffu + ((u >> 16) & 1u)) >> 16; }
__device__ __forceinline__ unsigned pk2(float lo, float hi) { return f2bf(lo) | (f2bf(hi) << 16); }
__device__ __forceinline__ float bf2f(unsigned short h) { return __builtin_bit_cast(float, (unsigned)h << 16); }
__device__ __forceinline__ float wave_sum(float v) {
#pragma unroll
    for (int o = 1; o < 64; o <<= 1) v += __shfl_xor(v, o);
    return v;
}
#define LDS_WAIT() asm volatile("s_waitcnt lgkmcnt(0)" ::: "memory")

__device__ __forceinline__ void p0_transpose_item(const float* W, int K, int Nsrc, int koff, const float* gain, int gain_lim, float cscale, bf16* WT, LAS float* scr, int kb, int nb, int lane) {
    const int k0 = 64 * kb, n0 = 64 * nb; const bool valid = n0 < Nsrc;
#pragma unroll 16
    for (int kk = 0; kk < 64; ++kk) {
        const int kd = k0 + kk; int ks = kd + koff; if (ks >= K) ks -= K;
        const float v = valid ? W[(size_t)ks * Nsrc + n0 + lane] : 0.f;
        const float g = (gain != nullptr && kd < gain_lim) ? gain[kd] : 1.f;
        scr[kk * 65 + lane] = v * g * cscale;
    }
    LDS_WAIT(); asm volatile("" ::: "memory");
    const int c = lane & 7;
#pragma unroll
    for (int j = 0; j < 8; ++j) { const int n = (lane >> 3) + 8 * j; const LAS float* s = scr + (8 * c) * 65 + n;
        v4u o; o.x = pk2(s[0 * 65], s[1 * 65]); o.y = pk2(s[2 * 65], s[3 * 65]); o.z = pk2(s[4 * 65], s[5 * 65]); o.w = pk2(s[6 * 65], s[7 * 65]);
        *(v4u*)(WT + (size_t)(n0 + n) * K + k0 + 8 * c) = o; }
    LDS_WAIT(); asm volatile("" ::: "memory");
}
__device__ __forceinline__ void rms_rows2_to_bf16(const float* xrow0, const float* xrow1, const float* g, bf16* orow0, bf16* orow1, int lane) {
    const f32x4* xr0 = (const f32x4*)xrow0 + lane; const f32x4* xr1 = (const f32x4*)xrow1 + lane; const f32x4* gr = (const f32x4*)g + lane;
    f32x4 v0[8], v1[8]; float s0 = 0.f, s1 = 0.f;
#pragma unroll
    for (int j = 0; j < 8; ++j) { v0[j] = xr0[64 * j]; v1[j] = xr1[64 * j]; }
#pragma unroll
    for (int j = 0; j < 8; ++j) { s0 += (v0[j].x * v0[j].x + v0[j].y * v0[j].y) + (v0[j].z * v0[j].z + v0[j].w * v0[j].w); s1 += (v1[j].x * v1[j].x + v1[j].y * v1[j].y) + (v1[j].z * v1[j].z + v1[j].w * v1[j].w); }
    const float r0 = rsqrtf(wave_sum(s0) * (1.f / 2048.f) + EPSN), r1 = rsqrtf(wave_sum(s1) * (1.f / 2048.f) + EPSN);
    v2u* o0 = (v2u*)orow0 + lane; v2u* o1 = (v2u*)orow1 + lane;
#pragma unroll
    for (int j = 0; j < 8; ++j) { const f32x4 gv = gr[64 * j];
        v2u a; a.x = pk2(v0[j].x * r0 * gv.x, v0[j].y * r0 * gv.y); a.y = pk2(v0[j].z * r0 * gv.z, v0[j].w * r0 * gv.w); o0[64 * j] = a;
        v2u b; b.x = pk2(v1[j].x * r1 * gv.x, v1[j].y * r1 * gv.y); b.y = pk2(v1[j].z * r1 * gv.z, v1[j].w * r1 * gv.w); o1[64 * j] = b; }
}
template <int NJ> __device__ __forceinline__ void p0_meta_item(const float* meta, const float* g, const float* w_in, int c0, int ncols, bf16* dst, int ld, int dcol0, u64* sskv, LAS unsigned char* lds, int wave, int lane) {
    LAS float* U = (LAS float*)lds;
#pragma unroll 1
    for (int rr = 0; rr < 2; ++rr) {
        const int row = 2 * wave + rr; const float* mr = meta + (size_t)row * 2048;
        float s = 0.f;
        for (int j = 0; j < 32; ++j) { const float v = mr[lane + 64 * j]; s += v * v; }
        const float rstd = rsqrtf(wave_sum(s) * (1.f / 2048.f) + EPSN);
        for (int j = 0; j < 32; ++j) { const int k = lane + 64 * j; U[row * 2048 + k] = mr[k] * rstd * g[k]; }
    }
    __syncthreads();
    float acc[16][NJ];
#pragma unroll
    for (int r = 0; r < 16; ++r)
#pragma unroll
        for (int j = 0; j < NJ; ++j) acc[r][j] = 0.f;
    const int kb = 256 * wave;
#pragma unroll 1
    for (int k = kb; k < kb + 256; k += 8) {
        float w[8][NJ];
#pragma unroll
        for (int u = 0; u < 8; ++u)
#pragma unroll
            for (int j = 0; j < NJ; ++j) { const int cc = lane + 64 * j; w[u][j] = (cc < ncols) ? w_in[(size_t)(k + u) * NINV + c0 + cc] : 0.f; }
#pragma unroll
        for (int r = 0; r < 16; ++r) {
            const f32x4 u0 = *(const LAS f32x4*)(U + r * 2048 + k), u1 = *(const LAS f32x4*)(U + r * 2048 + k + 4);
#pragma unroll
            for (int j = 0; j < NJ; ++j) acc[r][j] += (u0[0] * w[0][j] + u0[1] * w[1][j]) + (u0[2] * w[2][j] + u0[3] * w[3][j]) + (u1[0] * w[4][j] + u1[1] * w[5][j]) + (u1[2] * w[6][j] + u1[3] * w[7][j]);
        }
    }
    __syncthreads();
    LAS float* P = (LAS float*)lds;
#pragma unroll
    for (int r = 0; r < 16; ++r)
#pragma unroll
        for (int j = 0; j < NJ; ++j) P[(wave * 16 + r) * 256 + lane + 64 * j] = acc[r][j];
    __syncthreads();
#pragma unroll 1
    for (int rr = 0; rr < 2; ++rr) {
        const int row = 2 * wave + rr; float v[NJ]; float s = 0.f;
#pragma unroll
        for (int j = 0; j < NJ; ++j) { float t = 0.f;
#pragma unroll
            for (int w8 = 0; w8 < 8; ++w8) t += P[(w8 * 16 + row) * 256 + lane + 64 * j];
            v[j] = t; s += t * t; }
        s = wave_sum(s);
        for (int b = 0; b < NB; ++b) {
            const size_t rp = (size_t)b * LP + 48 + row;
#pragma unroll
            for (int j = 0; j < NJ; ++j) { const int cc = lane + 64 * j; if (cc < ncols) dst[rp * ld + dcol0 + cc] = (bf16)f2bf(v[j]); }
            if (sskv != nullptr && lane == 0) sskv[rp] = (u64)(s * FIXS);
        }
    }
    __syncthreads();
}

__device__ __forceinline__ void ret_naive(const bf16* RQ, const bf16* RK, const bf16* RV, const bf16* RG, const f32x2* ROPE, const float* retg, bf16* A2, int gw, int ngw, int lane) {
    for (int it = gw; it < NB * 8 * SEQ; it += ngw) {
        const int s = it & 2047, h = (it >> 11) & 7, b = it >> 14;
        const int r = b * SEQ + s, cn = 1 + (s >> 6), nabs = 64 + s;
        const float lg = log2f(1.0f - exp2f(-5.0f - (float)h));
        float q1 = bf2f(RQ[(size_t)r * 1024 + h * 128 + lane]), q2 = bf2f(RQ[(size_t)r * 1024 + h * 128 + 64 + lane]);
        { const f32x2 cs = ROPE[(16 + s) * 64 + lane]; const float a = q1 * cs.x - q2 * cs.y, c = q1 * cs.y + q2 * cs.x; q1 = a * 0.08838834764831845f; q2 = c * 0.08838834764831845f; }
        float o1 = 0.f, o2 = 0.f;
        const int pend = 64 * (cn + 1);
        for (int p = 48; p < pend; ++p) {
            const size_t rp = (size_t)b * LP + p;
            float k1 = bf2f(RK[rp * 1024 + h * 128 + lane]), k2 = bf2f(RK[rp * 1024 + h * 128 + 64 + lane]);
            const f32x2 cs = ROPE[(p - 48) * 64 + lane];
            const float ka = k1 * cs.x - k2 * cs.y, kc = k1 * cs.y + k2 * cs.x;
            const float d = wave_sum(q1 * ka + q2 * kc);
            const int dist = ((p >> 6) == cn) ? (nabs > p ? nabs - p : p - nabs) : (nabs - p);
            const float w = d * exp2f(lg * (float)dist);
            o1 += w * bf2f(RV[rp * 1024 + h * 128 + lane]); o2 += w * bf2f(RV[rp * 1024 + h * 128 + 64 + lane]);
        }
        const float mu = wave_sum(o1 + o2) * (1.f / 128.f);
        const float d1 = o1 - mu, d2 = o2 - mu;
        const float var = wave_sum(d1 * d1 + d2 * d2) * (1.f / 128.f);
        const float rs = rsqrtf(var + EPSN);
        const float g1 = bf2f(RG[(size_t)r * 1024 + h * 128 + lane]), g2 = bf2f(RG[(size_t)r * 1024 + h * 128 + 64 + lane]);
        const float y1 = d1 * rs * retg[h * 128 + lane] * (g1 / (1.f + __expf(-g1))), y2 = d2 * rs * retg[h * 128 + 64 + lane] * (g2 / (1.f + __expf(-g2)));
        A2[(size_t)r * 2048 + 1024 + h * 128 + lane] = (bf16)f2bf(y1); A2[(size_t)r * 2048 + 1024 + h * 128 + 64 + lane] = (bf16)f2bf(y2);
    }
}
__device__ __forceinline__ void mla_naive(const bf16* Q, const bf16* KN, const bf16* KR2, const bf16* VT, const f32x2* ROPE, bf16* A2, u64* ssmla, int gw, int ngw, int lane) {
    for (int it = gw; it < NB * 8 * SEQ; it += ngw) {
        const int s = it & 2047, h = (it >> 11) & 7, b = it >> 14;
        const int r = b * SEQ + s, cn = 1 + (s >> 6);
        const bf16* qb = Q + (size_t)r * 1536 + h * 192;
        const float q1 = bf2f(qb[lane]), q2 = bf2f(qb[64 + lane]);
        float qr1 = 0.f, qr2 = 0.f;
        if (lane < 32) { const float a = bf2f(qb[128 + lane]), c = bf2f(qb[160 + lane]); const f32x2 cs = ROPE[(16 + s) * 64 + 2 * lane]; qr1 = a * cs.x - c * cs.y; qr2 = a * cs.y + c * cs.x; }
        float m = -1e30f, l = 0.f, o1 = 0.f, o2 = 0.f;
        const int pend = 64 * (cn + 1);
        for (int p = 48; p < pend; ++p) {
            const size_t rp = (size_t)b * LP + p;
            float t = q1 * bf2f(KN[rp * 1024 + h * 128 + lane]) + q2 * bf2f(KN[rp * 1024 + h * 128 + 64 + lane]);
            if (lane < 32) t += qr1 * bf2f(KR2[rp * 64 + lane]) + qr2 * bf2f(KR2[rp * 64 + 32 + lane]);
            const float sc = wave_sum(t);
            const float mn = fmaxf(m, sc), al = exp2f(m - mn), pw = exp2f(sc - mn);
            l = l * al + pw;
            o1 = o1 * al + pw * bf2f(VT[(size_t)(h * 128 + lane) * MPAD + rp]); o2 = o2 * al + pw * bf2f(VT[(size_t)(h * 128 + 64 + lane) * MPAD + rp]);
            m = mn;
        }
        const float il = 1.f / l; o1 *= il; o2 *= il;
        const float ss = wave_sum(o1 * o1 + o2 * o2);
        if (lane == 0) atomicAdd(ssmla + r, (u64)(ss * FIXS));
        A2[(size_t)r * 2048 + h * 128 + lane] = (bf16)f2bf(o1); A2[(size_t)r * 2048 + h * 128 + 64 + lane] = (bf16)f2bf(o2);
    }
}

typedef float f32x16 __attribute__((ext_vector_type(16)));
typedef short bf16x8 __attribute__((ext_vector_type(8)));
typedef short bf16x4 __attribute__((ext_vector_type(4)));
__device__ __forceinline__ f32x16 mfma32(bf16x8 a, bf16x8 b, f32x16 c) { return __builtin_amdgcn_mfma_f32_32x32x16_bf16(a, b, c, 0, 0, 0); }
__device__ __forceinline__ unsigned cvtpk(float lo, float hi) { unsigned r; asm volatile("v_cvt_pk_bf16_f32 %0, %1, %2" : "=v"(r) : "v"(lo), "v"(hi)); return r; }
__device__ __forceinline__ bf16x8 pack8f(float a0, float a1, float a2, float a3, float a4, float a5, float a6, float a7) {
    v4u w; w.x = cvtpk(a0, a1); w.y = cvtpk(a2, a3); w.z = cvtpk(a4, a5); w.w = cvtpk(a6, a7); return __builtin_bit_cast(bf16x8, w); }
__device__ __forceinline__ bf16x8 cat44(bf16x4 a, bf16x4 b) { return __builtin_shufflevector(a, b, 0, 1, 2, 3, 4, 5, 6, 7); }
__device__ __forceinline__ float ex2(float x) { return __builtin_amdgcn_exp2f(x); }

constexpr int ATT_KROW = 400, ATT_KBYTES = 64 * ATT_KROW, ATT_VROW = 144, ATT_VBYTES = 128 * ATT_VROW, ATT_BUF = ATT_KBYTES + ATT_VBYTES;
__device__ __forceinline__ void mla_unit(LAS unsigned char* lds, const bf16* Q, const bf16* KN, const bf16* KR2, const bf16* VT, const f32x2* ROPE, bf16* A2, u64* ssmla, int b, int h, int qblk, int tid) {
    const int lane = tid & 63, wave = __builtin_amdgcn_readfirstlane(tid >> 6), l31 = lane & 31, hi = lane >> 5;
    const int sq = qblk * 256 + wave * 32 + l31;
    const size_t rq = (size_t)b * SEQ + sq;
    const int ntiles = 4 * qblk + 5, ktmax = 4 * qblk + 1 + (wave >> 1);
    const size_t prow0 = (size_t)b * LP;
    v4u st[5];
#define ATT_ADDR() int tq_ = tid; asm volatile("" : "+v"(tq_)); const int kkey0 = tq_ >> 4, kpc = tq_ & 15, rkey = tq_ >> 3, rpc = tq_ & 7; \
        const bf16* gkn = KN + (prow0 + kkey0) * 1024 + h * 128 + kpc * 8; const bf16* gkr = KR2 + (prow0 + rkey) * 64 + rpc * 8; const bf16* gvt = VT + (size_t)(h * 128 + rkey) * MPAD + prow0 + rpc * 8
#define ATT_LOAD(kt) do { ATT_ADDR(); st[0] = *(const v4u*)(gkn + (size_t)(kt) * 65536); st[1] = *(const v4u*)(gkn + (size_t)(kt) * 65536 + 32768); st[2] = *(const v4u*)(gkr + (size_t)(kt) * 4096); \
        st[3] = *(const v4u*)(gvt + (kt) * 64); st[4] = *(const v4u*)(gvt + (size_t)64 * MPAD + (kt) * 64); } while (0)
#define ATT_WRITE(bo) do { int tw_ = tid; asm volatile("" : "+v"(tw_)); const int lkn = (tw_ >> 4) * ATT_KROW + (tw_ & 15) * 16, lkr = (tw_ >> 3) * ATT_KROW + 256 + (tw_ & 7) * 16, lvt = ATT_KBYTES + (tw_ >> 3) * ATT_VROW + ((tw_ & 7) >> 1) * 32 + (tw_ & 1) * 8; \
        LAS unsigned char* w_ = lds + (bo); *(LAS v4u*)(w_ + lkn) = st[0]; *(LAS v4u*)(w_ + lkn + 32 * ATT_KROW) = st[1]; *(LAS v4u*)(w_ + lkr) = st[2]; \
        *(LAS v2u*)(w_ + lvt) = (v2u){st[3].x, st[3].y}; *(LAS v2u*)(w_ + lvt + 16) = (v2u){st[3].z, st[3].w}; \
        *(LAS v2u*)(w_ + lvt + 64 * ATT_VROW) = (v2u){st[4].x, st[4].y}; *(LAS v2u*)(w_ + lvt + 64 * ATT_VROW + 16) = (v2u){st[4].z, st[4].w}; } while (0)
    ATT_LOAD(0);
    bf16x8 qf[12];
    { const bf16* qp = Q + rq * 1536 + h * 192 + 8 * hi;
#pragma unroll
      for (int kk = 0; kk < 12; ++kk) qf[kk] = *(const bf16x8*)(qp + 16 * kk);
#pragma unroll
      for (int k2 = 0; k2 < 2; ++k2)
#pragma unroll
          for (int j = 0; j < 8; ++j) { const int t = 16 * k2 + 8 * hi + j; const f32x2 cs = ROPE[(16 + sq) * 64 + 2 * t];
              const float x1 = bf2f((unsigned short)qf[8 + k2][j]), x2 = bf2f((unsigned short)qf[10 + k2][j]);
              qf[8 + k2][j] = (short)f2bf(x1 * cs.x - x2 * cs.y); qf[10 + k2][j] = (short)f2bf(x1 * cs.y + x2 * cs.x); } }
    f32x16 oacc[4];
#pragma unroll
    for (int e = 0; e < 4; ++e)
#pragma unroll
        for (int r = 0; r < 16; ++r) oacc[e][r] = 0.f;
    float m = 0.f, l = 0.f;
    ATT_WRITE(0); __syncthreads();
#pragma unroll 1
    for (int kt = 0; kt < ntiles; ++kt) {
        const int bo = (kt & 1) * ATT_BUF;
        int tl_ = lane; asm volatile("" : "+v"(tl_)); const int koff = (tl_ & 31) * ATT_KROW + (tl_ >> 5) * 16, voff = ATT_KBYTES + (tl_ & 31) * ATT_VROW + (tl_ >> 5) * 16;
        if (kt + 1 < ntiles) ATT_LOAD(kt + 1);
        if (kt <= ktmax) {
            f32x16 s0, s1;
#pragma unroll
            for (int r = 0; r < 16; ++r) { s0[r] = -m; s1[r] = -m; }
            bf16x8 ka[2][2], kb[2][2];
#define ATT_KLD(bi, kk0) do { ka[bi][0] = *(const LAS bf16x8*)(lds + bo + koff + (kk0) * 32); kb[bi][0] = *(const LAS bf16x8*)(lds + bo + koff + 32 * ATT_KROW + (kk0) * 32); \
        ka[bi][1] = *(const LAS bf16x8*)(lds + bo + koff + (kk0) * 32 + 32); kb[bi][1] = *(const LAS bf16x8*)(lds + bo + koff + 32 * ATT_KROW + (kk0) * 32 + 32); } while (0)
            ATT_KLD(0, 0);
            __builtin_amdgcn_sched_barrier(0);
#pragma unroll
            for (int bt = 0; bt < 6; ++bt) {
                if (bt < 5) ATT_KLD((bt + 1) & 1, 2 * (bt + 1));
                __builtin_amdgcn_sched_barrier(0);
                s0 = mfma32(ka[bt & 1][0], qf[2 * bt], s0); s1 = mfma32(kb[bt & 1][0], qf[2 * bt], s1);
                s0 = mfma32(ka[bt & 1][1], qf[2 * bt + 1], s0); s1 = mfma32(kb[bt & 1][1], qf[2 * bt + 1], s1);
                __builtin_amdgcn_sched_barrier(0);
            }
#undef ATT_KLD
            if (kt == 0) {
                asm volatile("" ::: "memory");
#pragma unroll
                for (int r = 0; r < 16; ++r) s0[r] = -1e30f;
#pragma unroll
                for (int r = 0; r < 8; ++r) s1[r] = -1e30f;
            }
            float mxa, mxb;
            asm("v_max3_f32 %0, %1, %2, %3" : "=v"(mxa) : "v"(s0[0]), "v"(s0[1]), "v"(s0[2]));
            asm("v_max3_f32 %0, %1, %2, %3" : "=v"(mxb) : "v"(s1[0]), "v"(s1[1]), "v"(s1[2]));
#pragma unroll
            for (int r = 3; r < 15; r += 2) { asm("v_max3_f32 %0, %1, %2, %3" : "=v"(mxa) : "v"(mxa), "v"(s0[r]), "v"(s0[r + 1])); asm("v_max3_f32 %0, %1, %2, %3" : "=v"(mxb) : "v"(mxb), "v"(s1[r]), "v"(s1[r + 1])); }
            float mx; asm("v_max3_f32 %0, %1, %2, %3" : "=v"(mx) : "v"(mxa), "v"(mxb), "v"(s0[15]));
            mx = fmaxf(mx, s1[15]);
            mx = fmaxf(mx, __shfl_xor(mx, 32));
            if (kt == 0 || __builtin_amdgcn_ballot_w64(mx > 8.0f) != 0ull) {
                const float sh = kt == 0 ? mx : fmaxf(mx, 0.f), al = ex2(-sh); m += sh;
                l *= al;
#pragma unroll
                for (int r = 0; r < 16; ++r) { s0[r] -= sh; s1[r] -= sh; }
#pragma unroll
                for (int e = 0; e < 4; ++e)
#pragma unroll
                    for (int r = 0; r < 16; ++r) oacc[e][r] *= al;
            }
            float ps = 0.f;
#pragma unroll
            for (int r = 0; r < 16; ++r) { s0[r] = ex2(s0[r]); s1[r] = ex2(s1[r]); ps += s0[r] + s1[r]; }
            l += ps;
            bf16x8 pb[4];
            pb[0] = pack8f(s0[0], s0[1], s0[2], s0[3], s0[4], s0[5], s0[6], s0[7]); pb[1] = pack8f(s0[8], s0[9], s0[10], s0[11], s0[12], s0[13], s0[14], s0[15]);
            pb[2] = pack8f(s1[0], s1[1], s1[2], s1[3], s1[4], s1[5], s1[6], s1[7]); pb[3] = pack8f(s1[8], s1[9], s1[10], s1[11], s1[12], s1[13], s1[14], s1[15]);
            bf16x8 vv[2][4];
#define ATT_VLD(bi, t) do { _Pragma("unroll") for (int e = 0; e < 4; ++e) vv[bi][e] = *(const LAS bf16x8*)(lds + bo + voff + e * 32 * ATT_VROW + (t) * 32); } while (0)
            ATT_VLD(0, 0);
            __builtin_amdgcn_sched_barrier(0);
#pragma unroll
            for (int t = 0; t < 4; ++t) {
                if (t < 3) ATT_VLD((t + 1) & 1, t + 1);
                __builtin_amdgcn_sched_barrier(0);
#pragma unroll
                for (int e = 0; e < 4; ++e) oacc[e] = mfma32(vv[t & 1][e], pb[t], oacc[e]);
                __builtin_amdgcn_sched_barrier(0);
            }
#undef ATT_VLD
        }
        if (kt + 1 < ntiles) ATT_WRITE(((kt + 1) & 1) * ATT_BUF);
        __syncthreads();
    }
#undef ATT_LOAD
#undef ATT_WRITE
#undef ATT_ADDR
    l += __shfl_xor(l, 32);
    const float il = 1.f / l;
    float ss = 0.f;
    bf16* op = A2 + rq * 2048 + h * 128 + 4 * hi;
#pragma unroll
    for (int e = 0; e < 4; ++e)
#pragma unroll
        for (int g4 = 0; g4 < 4; ++g4) {
            const float o0 = oacc[e][4 * g4] * il, o1 = oacc[e][4 * g4 + 1] * il, o2 = oacc[e][4 * g4 + 2] * il, o3 = oacc[e][4 * g4 + 3] * il;
            ss += (o0 * o0 + o1 * o1) + (o2 * o2 + o3 * o3);
            *(v2u*)(op + 32 * e + 8 * g4) = (v2u){cvtpk(o0, o1), cvtpk(o2, o3)};
        }
    ss += __shfl_xor(ss, 32);
    if (hi == 0) atomicAdd(ssmla + rq, (u64)(ss * FIXS));
}

constexpr int RT_ROW = 272, RT_TROW = 144, RT_QS = 0, RT_KS = 64 * RT_ROW, RT_KT = 2 * 64 * RT_ROW, RT_VT = RT_KT + 128 * RT_TROW, RT_ST = RT_VT + 128 * RT_TROW, RT_DT = RT_ST + 2048;
__device__ __forceinline__ void ret_unit(LAS unsigned char* lds, const bf16* RQ, const bf16* RK, const bf16* RV, const bf16* RG, const f32x2* ROPE, const float* retg, bf16* A2, int b, int h, int tid) {
    const int lane = tid & 63, wave = __builtin_amdgcn_readfirstlane(tid >> 6), l31 = lane & 31, hi = lane >> 5, eb = wave & 3, ib = wave >> 2;
    const float lg = log2f(1.0f - exp2f(-5.0f - (float)h));
    const float dec64 = ex2(lg * 64.0f);
    const int sj = tid & 63, spc = wave;
    f32x16 S[4];
#pragma unroll
    for (int d = 0; d < 4; ++d)
#pragma unroll
        for (int r = 0; r < 16; ++r) S[d][r] = 0.f;
    v4u rk0, rk1, rv0, rv1, rq0 = (v4u){0u, 0u, 0u, 0u}, rq1 = (v4u){0u, 0u, 0u, 0u}; f32x4 cs[4];
#define RT_LOAD(n) do { const size_t rowp_ = (size_t)b * LP + 64 * (n) + sj; const bf16* kp_ = RK + rowp_ * 1024 + h * 128 + 8 * spc; const bf16* vp_ = RV + rowp_ * 1024 + h * 128 + 8 * spc; \
        rk0 = *(const v4u*)kp_; rk1 = *(const v4u*)(kp_ + 64); rv0 = *(const v4u*)vp_; rv1 = *(const v4u*)(vp_ + 64); \
        if ((n) >= 1) { const bf16* qp_ = RQ + ((size_t)b * SEQ + 64 * ((n) - 1) + sj) * 1024 + h * 128 + 8 * spc; rq0 = *(const v4u*)qp_; rq1 = *(const v4u*)(qp_ + 64); } \
        const int p_ = 64 * (n) + sj; const int pos_ = p_ < 48 ? 0 : p_ - 48; const f32x4* cp_ = (const f32x4*)(ROPE + pos_ * 64 + 8 * spc); cs[0] = cp_[0]; cs[1] = cp_[1]; cs[2] = cp_[2]; cs[3] = cp_[3]; } while (0)
    if (tid < 127) { const int dx = tid < 63 ? 63 - tid : tid - 63; *(LAS float*)(lds + RT_DT + 4 * tid) = ex2(lg * (float)dx); }
    RT_LOAD(0);
#pragma unroll 1
    for (int n = 0; n <= 32; ++n) {
        int tq = tid; asm volatile("" : "+v"(tq));
        const int lane = tq & 63, l31 = lane & 31, hi = lane >> 5, sj = lane, spc = wave;
        const float wk = ex2(lg * (float)(63 - sj));
        {
            const bf16x8 v0v = __builtin_bit_cast(bf16x8, rv0), v1v = __builtin_bit_cast(bf16x8, rv1);
#pragma unroll
            for (int e = 0; e < 8; ++e) {
                *(LAS unsigned short*)(lds + RT_VT + (8 * spc + e) * RT_TROW + 2 * sj) = (unsigned short)v0v[e];
                *(LAS unsigned short*)(lds + RT_VT + (64 + 8 * spc + e) * RT_TROW + 2 * sj) = (unsigned short)v1v[e];
            }
        }
        __builtin_amdgcn_sched_barrier(0);
        {
            float ka[8], kb[8];
            const bf16x8 k0v = __builtin_bit_cast(bf16x8, rk0), k1v = __builtin_bit_cast(bf16x8, rk1);
#pragma unroll
            for (int e = 0; e < 8; ++e) {
                const float c = cs[e >> 1][2 * (e & 1)], s = cs[e >> 1][2 * (e & 1) + 1];
                const float k1 = bf2f((unsigned short)k0v[e]), k2 = bf2f((unsigned short)k1v[e]);
                ka[e] = k1 * c - k2 * s; kb[e] = k1 * s + k2 * c;
            }
            *(LAS bf16x8*)(lds + RT_KS + sj * RT_ROW + 16 * spc) = pack8f(ka[0], ka[1], ka[2], ka[3], ka[4], ka[5], ka[6], ka[7]);
            *(LAS bf16x8*)(lds + RT_KS + sj * RT_ROW + 128 + 16 * spc) = pack8f(kb[0], kb[1], kb[2], kb[3], kb[4], kb[5], kb[6], kb[7]);
#pragma unroll
            for (int e = 0; e < 8; ++e) {
                const unsigned pk_ = cvtpk(ka[e] * wk, kb[e] * wk);
                *(LAS unsigned short*)(lds + RT_KT + (8 * spc + e) * RT_TROW + 2 * sj) = (unsigned short)(pk_ & 0xffffu);
                *(LAS unsigned short*)(lds + RT_KT + (64 + 8 * spc + e) * RT_TROW + 2 * sj) = (unsigned short)(pk_ >> 16);
            }
        }
        __builtin_amdgcn_sched_barrier(0);
        {
            float qa[8], qb[8];
            const bf16x8 q0v = __builtin_bit_cast(bf16x8, rq0), q1v = __builtin_bit_cast(bf16x8, rq1);
#pragma unroll
            for (int e = 0; e < 8; ++e) {
                const float c = cs[e >> 1][2 * (e & 1)], s = cs[e >> 1][2 * (e & 1) + 1];
                const float q1 = bf2f((unsigned short)q0v[e]), q2 = bf2f((unsigned short)q1v[e]);
                qa[e] = (q1 * c - q2 * s) * 0.08838834764831845f; qb[e] = (q1 * s + q2 * c) * 0.08838834764831845f;
            }
            *(LAS bf16x8*)(lds + RT_QS + sj * RT_ROW + 16 * spc) = pack8f(qa[0], qa[1], qa[2], qa[3], qa[4], qa[5], qa[6], qa[7]);
            *(LAS bf16x8*)(lds + RT_QS + sj * RT_ROW + 128 + 16 * spc) = pack8f(qb[0], qb[1], qb[2], qb[3], qb[4], qb[5], qb[6], qb[7]);
        }
        asm volatile("s_waitcnt lgkmcnt(0)" ::: "memory"); __builtin_amdgcn_s_barrier(); asm volatile("" ::: "memory");
        v2u grv[4]; f32x4 gnv[4];
        { const float* rgp = retg; asm volatile("" : "+s"(rgp));
          const size_t rowq_ = (size_t)b * SEQ + 64 * (n >= 1 ? n - 1 : 0) + 32 * ib + l31;
#pragma unroll
          for (int g4 = 0; g4 < 4; ++g4) { const int e0 = h * 128 + 32 * eb + 8 * g4 + 4 * hi; gnv[g4] = *(const f32x4*)(rgp + e0); grv[g4] = *(const v2u*)(RG + rowq_ * 1024 + e0); } }
        f32x16 o;
        if (n >= 1) {
            f32x16 s0, s1;
#pragma unroll
            for (int r = 0; r < 16; ++r) { s0[r] = 0.f; s1[r] = 0.f; }
#pragma unroll
            for (int kk = 0; kk < 8; ++kk) {
                const bf16x8 qv = *(const LAS bf16x8*)(lds + RT_QS + (32 * ib + l31) * RT_ROW + kk * 32 + hi * 16);
                const bf16x8 a0 = *(const LAS bf16x8*)(lds + RT_KS + l31 * RT_ROW + kk * 32 + hi * 16), a1 = *(const LAS bf16x8*)(lds + RT_KS + (32 + l31) * RT_ROW + kk * 32 + hi * 16);
                s0 = mfma32(a0, qv, s0); s1 = mfma32(a1, qv, s1);
            }
            const int iq = 32 * ib + l31;
            {
                const LAS float* dt = (const LAS float*)(lds + RT_DT) + (iq - 4 * hi + 63);
#pragma unroll
                for (int r = 0; r < 16; ++r) { const int c = (r & 3) + 8 * (r >> 2); s0[r] *= dt[-c]; s1[r] *= dt[-c - 32]; }
            }
            bf16x8 pb[4];
            pb[0] = pack8f(s0[0], s0[1], s0[2], s0[3], s0[4], s0[5], s0[6], s0[7]); pb[1] = pack8f(s0[8], s0[9], s0[10], s0[11], s0[12], s0[13], s0[14], s0[15]);
            pb[2] = pack8f(s1[0], s1[1], s1[2], s1[3], s1[4], s1[5], s1[6], s1[7]); pb[3] = pack8f(s1[8], s1[9], s1[10], s1[11], s1[12], s1[13], s1[14], s1[15]);
            f32x16 oI, oX;
#pragma unroll
            for (int r = 0; r < 16; ++r) { oI[r] = 0.f; oX[r] = 0.f; }
#pragma unroll
            for (int t = 0; t < 4; ++t) {
                const bf16x4 vlo = *(const LAS bf16x4*)(lds + RT_VT + (32 * eb + l31) * RT_TROW + t * 32 + hi * 8), vhi = *(const LAS bf16x4*)(lds + RT_VT + (32 * eb + l31) * RT_TROW + t * 32 + 16 + hi * 8);
                oI = mfma32(cat44(vlo, vhi), pb[t], oI);
            }
#pragma unroll
            for (int db = 0; db < 4; ++db)
#pragma unroll
                for (int t = 0; t < 2; ++t) {
                    const bf16x8 sa = pack8f(S[db][8 * t], S[db][8 * t + 1], S[db][8 * t + 2], S[db][8 * t + 3], S[db][8 * t + 4], S[db][8 * t + 5], S[db][8 * t + 6], S[db][8 * t + 7]);
                    const bf16x4 qlo = *(const LAS bf16x4*)(lds + RT_QS + iq * RT_ROW + (32 * db + 16 * t + 4 * hi) * 2), qhi = *(const LAS bf16x4*)(lds + RT_QS + iq * RT_ROW + (32 * db + 16 * t + 8 + 4 * hi) * 2);
                    oX = mfma32(sa, cat44(qlo, qhi), oX);
                }
            const float wq = ex2(lg * (float)(iq + 1));
#pragma unroll
            for (int r = 0; r < 16; ++r) o[r] = oI[r] + wq * oX[r];
        }
        if (n < 32) RT_LOAD(n + 1);
        if (n < 32) {
#pragma unroll
            for (int db = 0; db < 4; ++db) {
#pragma unroll
                for (int r = 0; r < 16; ++r) S[db][r] *= dec64;
#pragma unroll
                for (int t = 0; t < 4; ++t) {
                    const bf16x8 ka8 = *(const LAS bf16x8*)(lds + RT_KT + (32 * db + l31) * RT_TROW + t * 32 + hi * 16);
                    const bf16x8 vb8 = *(const LAS bf16x8*)(lds + RT_VT + (32 * eb + l31) * RT_TROW + t * 32 + hi * 16);
                    S[db] = mfma32(ka8, vb8, S[db]);
                }
            }
        }
        if (n >= 1) {
            float t1 = 0.f, t2 = 0.f;
#pragma unroll
            for (int r = 0; r < 16; ++r) { t1 += o[r]; t2 += o[r] * o[r]; }
            t1 += __shfl_xor(t1, 32); t2 += __shfl_xor(t2, 32);
            if (hi == 0) *(LAS f32x2*)(lds + RT_ST + ((ib * 4 + eb) * 32 + l31) * 8) = (f32x2){t1, t2};
        }
        asm volatile("s_waitcnt lgkmcnt(0)" ::: "memory"); __builtin_amdgcn_s_barrier(); asm volatile("" ::: "memory");
        if (n >= 1) {
            float t1 = 0.f, t2 = 0.f;
#pragma unroll
            for (int e4 = 0; e4 < 4; ++e4) { const f32x2 p = *(const LAS f32x2*)(lds + RT_ST + ((ib * 4 + e4) * 32 + l31) * 8); t1 += p.x; t2 += p.y; }
            const float mu = t1 * (1.f / 128.f), var = t2 * (1.f / 128.f) - mu * mu, rs = rsqrtf(fmaxf(var, 0.f) + EPSN);
            const size_t rowq = (size_t)b * SEQ + 64 * (n - 1) + 32 * ib + l31;
#pragma unroll
            for (int g4 = 0; g4 < 4; ++g4) {
                const int e0 = h * 128 + 32 * eb + 8 * g4 + 4 * hi;
                const f32x4 gv = gnv[g4]; const v2u gr = grv[g4];
                const float g0 = bf2f((unsigned short)(gr.x & 0xffffu)), g1 = bf2f((unsigned short)(gr.x >> 16)), g2 = bf2f((unsigned short)(gr.y & 0xffffu)), g3 = bf2f((unsigned short)(gr.y >> 16));
#define RT_SILU(g) ((g) * __builtin_amdgcn_rcpf(1.f + ex2((g) * -1.4426950408889634f)))
                const float y0 = (o[4 * g4] - mu) * rs * gv.x * RT_SILU(g0), y1 = (o[4 * g4 + 1] - mu) * rs * gv.y * RT_SILU(g1);
                const float y2 = (o[4 * g4 + 2] - mu) * rs * gv.z * RT_SILU(g2), y3 = (o[4 * g4 + 3] - mu) * rs * gv.w * RT_SILU(g3);
#undef RT_SILU
                *(v2u*)(A2 + rowq * 2048 + 1024 + e0) = (v2u){cvtpk(y0, y1), cvtpk(y2, y3)};
            }
        }
    }
#undef RT_LOAD
}

#define XB_TMO      128
#define XB_XCNT(j)  (256  + 64 * (j))
#define XB_XSUB(j)  (1280 + 64 * (j))
#define XB_XGEN(j)  (2304 + 64 * (j))
#define XB_TOP      3328
#define XB_TOPGEN   3392
#define XCD_BAR_WORDS 3456
#define XB_SPIN_CAP (1u << 22)

__device__ __forceinline__ unsigned xb_ld(unsigned* p)              { return __hip_atomic_load(p, __ATOMIC_RELAXED, __HIP_MEMORY_SCOPE_AGENT); }
__device__ __forceinline__ unsigned xb_add(unsigned* p, unsigned v) { return __hip_atomic_fetch_add(p, v, __ATOMIC_RELAXED, __HIP_MEMORY_SCOPE_AGENT); }
__device__ __forceinline__ unsigned xb_xcc_id() { return (unsigned)__builtin_amdgcn_s_getreg((3 << 11) | 20) & 0xFu; }
#define XB_SPIN(cond, bar) do { unsigned _sp = 0; while (cond) { __builtin_amdgcn_s_sleep(1); \
    if ((++_sp & 255u) == 0u) { if (xb_ld(&(bar)[XB_TMO])) break; if (_sp > XB_SPIN_CAP) { atomicAdd(&(bar)[XB_TMO], 1u); break; } } } } while (0)

struct XcdBarrier {
    unsigned* bar; unsigned x;
    volatile LAS unsigned* st;
};

__device__ __forceinline__ XcdBarrier xcd_barrier_post(unsigned* bar, volatile LAS unsigned* st) {
    XcdBarrier b; b.bar = bar; b.x = xb_xcc_id(); b.st = st;
    if (threadIdx.x == 0) (void)xb_add(&bar[XB_XCNT(b.x)], 1u);
    return b;
}
__device__ __forceinline__ void xcd_barrier_complete(unsigned* bar, unsigned x, unsigned& nloc, unsigned& nx) {
    const unsigned G = gridDim.x * gridDim.y * gridDim.z;
    unsigned sum, cnt, mine, sp = 0u;
    for (;;) {
        sum = 0u; cnt = 0u; mine = 0u;
#pragma unroll
        for (unsigned j = 0; j < 16; ++j) { const unsigned c = xb_ld(&bar[XB_XCNT(j)]); sum += c; cnt += (c > 0u) ? 1u : 0u; mine = (j == x) ? c : mine; }
        if (sum == G) break;
        __builtin_amdgcn_s_sleep(1);
        if ((++sp & 255u) == 0u) { if (xb_ld(&bar[XB_TMO])) break; if (sp > XB_SPIN_CAP) { atomicAdd(&bar[XB_TMO], 1u); break; } }
    }
    nloc = mine > 0u ? mine : 1u; nx = cnt > 0u ? cnt : 1u;
}

__device__ __forceinline__ void xcd_barrier(const XcdBarrier& b) {
    asm volatile("s_waitcnt vmcnt(0)" ::: "memory");
    __syncthreads();
    if (threadIdx.x == 0) {
        unsigned* bar = b.bar;
        __builtin_amdgcn_s_waitcnt(0);
        unsigned nloc = b.st[0], nx = b.st[1];
        if (nloc == 0u) { xcd_barrier_complete(bar, b.x, nloc, nx); b.st[0] = nloc; b.st[1] = nx; }
        const unsigned old = xb_add(&bar[XB_XSUB(b.x)], 1u);
        const unsigned gen = old / nloc;
        if (old + 1u == (gen + 1u) * nloc) {
            __builtin_amdgcn_fence(__ATOMIC_RELEASE, "agent");
            asm volatile("s_waitcnt vmcnt(0)" ::: "memory");
            const unsigned og = xb_add(&bar[XB_TOP], 1u);
            const unsigned tg = og / nx;
            if (og + 1u == (tg + 1u) * nx) xb_add(&bar[XB_TOPGEN], 1u);
            else XB_SPIN(xb_ld(&bar[XB_TOPGEN]) == tg, bar);
            __builtin_amdgcn_fence(__ATOMIC_ACQUIRE, "agent");
            xb_add(&bar[XB_XGEN(b.x)], 1u);
            asm volatile("s_waitcnt vmcnt(0)" ::: "memory");
        } else {
            XB_SPIN(xb_ld(&bar[XB_XGEN(b.x)]) == gen, bar);
            __builtin_amdgcn_fence(__ATOMIC_ACQUIRE, "agent");
            asm volatile("s_waitcnt vmcnt(0)" ::: "memory");
        }
    }
    __syncthreads();
}

struct Args { const float* in[16]; float* out; unsigned char* ws; int ph_lo, ph_hi, dummy, pad; };
constexpr size_t WS_DUMMY = 906 * MiB;
#ifndef PROBE_SEQ
#define PROBE_SEQ 0, 1, 2, 3, 4, 5, 6
#endif
constexpr int NPHASE = 7;
constexpr size_t WS_SSFIN = 904 * MiB, WS_CNT = 905 * MiB, WS_BAR = 905 * MiB + 512 * 1024;
__global__ void __launch_bounds__(512, 2) hymba_fwd(Args args) {
    extern __shared__ __attribute__((aligned(16))) unsigned char lds_raw[];
    LAS unsigned char* lds = (LAS unsigned char*)lds_raw;
    cg::grid_group grid = cg::this_grid();
    typedef const __attribute__((address_space(4))) Args* ArgsCP;
    ArgsCP ap_ = (ArgsCP)__builtin_amdgcn_kernarg_segment_ptr();
#define PHASE_BEGIN() ArgsCP ap = ap_; asm volatile("" : "+s"(ap)); unsigned char* ws = ap->ws; asm volatile("" : "+s"(ws)); int tid = threadIdx.x; asm volatile("" : "+v"(tid)); \
    const int lane = tid & 63, wave = __builtin_amdgcn_readfirstlane(tid >> 6); const int G = gridDim.x, bx = blockIdx.x; \
    const int gw = bx * 8 + wave, ngw = G * 8, gtid = bx * 512 + tid, ngt = G * 512; (void)lane; (void)wave; (void)gw; (void)ngw; (void)gtid; (void)ngt; (void)ws
#define INP(i) (ap->in[i])
#define WSB(off) ((bf16*)(ws + (off)))
#define WSU(off) ((u64*)(ws + (off)))
    const int lo = args.ph_lo, hi = args.ph_hi;
#define IN(k) (lo <= (k) && (k) < hi)
#define SEAM(k) do { if (IN(k) && IN((k) + 1)) xcd_barrier(xbar); } while (0)
    if (threadIdx.x < 16) ((LAS unsigned*)(lds + LDS_BYTES - 64))[threadIdx.x] = 0u;
    __syncthreads();
    if (ap_->ph_hi > 64) grid.sync();
    XcdBarrier xbar; xbar.bar = nullptr; xbar.x = 0; xbar.st = nullptr;
    if (hi - lo > 1) xbar = xcd_barrier_post((unsigned*)(ap_->ws + WS_BAR), (volatile LAS unsigned*)(lds + LDS_BYTES - 64));

    if (IN(0)) {
        PHASE_BEGIN();
        const float* x = INP(0); const float* meta = INP(1); const float* g_mix = INP(2); const float* w_in = INP(3);
        u64* SSQ = WSU(WS_SSQ); u64* SSKV = WSU(WS_SSKV); u64* SSMLA = WSU(WS_SSMLA); u64* SSH1 = WSU(WS_SSH1); f32x2* ROPE = (f32x2*)(ws + WS_ROPE);
        bf16* RK = WSB(WS_RK); bf16* RV = WSB(WS_RV); bf16* CKV = WSB(WS_CKV); bf16* KRAW = WSB(WS_KRAW); bf16* XN = WSB(WS_XN);
        LAS float* scr = (LAS float*)(lds + wave * 16640);
        constexpr int I1 = 32 * 80, I2 = 8 * 24, I3 = 4 * 16, I4 = 4 * 16, I5 = 32 * 32, I6 = 32 * 128, I7 = 128 * 32;
        constexpr int NITEMS = I1 + I2 + I3 + I4 + 3 * (I6 / 4); (void)I5; (void)I7;
        constexpr float QSCALE = 0.07216878364870323f * 1.4426950408889634f;
        const int pf = ap->dummy;
        if (!(pf & 2))
        for (int it = gw; it < NITEMS; it += ngw) {
            int r = it;
            if (r < I1) { p0_transpose_item(w_in, 2048, NINV, 0, nullptr, 0, 1.f, WSB(WS_WIN), scr, r / 80, r % 80, lane); continue; } r -= I1;
            if (r < I2) { p0_transpose_item(INP(6), 512, 1536, 0, INP(5), 512, QSCALE, WSB(WS_WUQ), scr, r / 24, r % 24, lane); continue; } r -= I2;
            if (r < I3) { p0_transpose_item(INP(8), 256, 1024, 0, INP(7), 256, 1.f, WSB(WS_WUK), scr, r / 16, r % 16, lane); continue; } r -= I3;
            if (r < I4) { p0_transpose_item(INP(9), 256, 1024, 0, INP(7), 256, 1.f, WSB(WS_WUV), scr, r / 16, r % 16, lane); continue; } r -= I4;
            p0_transpose_item(INP(13), 2048, 8192, 0, INP(12), 2048, 1.f, WSB(WS_WUP), scr, r / 128, r % 128, lane);
        }
        if (!(pf & 4))
        {
            const int nx = (G > 68 ? G - 34 : G) * 8;
            if (gw < nx) for (int m = 2 * gw; m < MROWS; m += 2 * nx) rms_rows2_to_bf16(x + (size_t)m * DM, x + (size_t)(m + 1) * DM, g_mix, XN + (size_t)m * DM, XN + (size_t)(m + 1) * DM, lane);
        }
        if (!(pf & 8)) {
        for (int i = gtid; i < NPOS * 64; i += ngt) {
            const int pos = i >> 6, f = i & 63;
            const float inv = 1.0f / powf(10000.0f, (float)(2 * f) / 128.0f);
            const float ang = (float)pos * inv;
            ROPE[i] = (f32x2){cosf(ang), sinf(ang)};
        }
        for (int i = gtid; i < MROWS; i += ngt) { SSQ[i] = 0ull; SSMLA[i] = 0ull; SSH1[i] = 0ull; WSU(WS_SSFIN)[i] = 0ull; }
        for (int i = gtid; i < 128 * 64; i += ngt) ((unsigned*)(ws + WS_CNT))[i] = 0u;
        for (int i = gtid; i < MPAD; i += ngt) { const int p = i % LP; if (p < 48 || p >= 64) SSKV[i] = 0ull; }
        const v4u z4 = (v4u){0u, 0u, 0u, 0u};
        for (int i = gtid; i < NB * 48 * 128; i += ngt) { const int row = i >> 7, pc = i & 127; const size_t rp = (size_t)(row / 48) * LP + (row % 48); *(v4u*)(RK + rp * 1024 + pc * 8) = z4; *(v4u*)(RV + rp * 1024 + pc * 8) = z4; }
        for (int i = gtid; i < NB * 48 * 32; i += ngt) { const int row = i >> 5, pc = i & 31; const size_t rp = (size_t)(row / 48) * LP + (row % 48); *(v4u*)(CKV + rp * 256 + pc * 8) = z4; }
        for (int i = gtid; i < NB * 48 * 8; i += ngt) { const int row = i >> 3, pc = i & 7; const size_t rp = (size_t)(row / 48) * LP + (row % 48); *(v4u*)(KRAW + rp * 64 + pc * 8) = z4; }
        const int mi = G - 1 - bx;
        if (mi < 34) {
            __syncthreads();
            if (mi < 16)       p0_meta_item<1>(meta, g_mix, w_in, 1024 + 64 * mi, 64, RK, 1024, 64 * mi, nullptr, lds, wave, lane);
            else if (mi < 32)  p0_meta_item<1>(meta, g_mix, w_in, 2048 + 64 * (mi - 16), 64, RV, 1024, 64 * (mi - 16), nullptr, lds, wave, lane);
            else if (mi == 32) p0_meta_item<1>(meta, g_mix, w_in, 4864, 64, KRAW, 64, 0, nullptr, lds, wave, lane);
            else               p0_meta_item<4>(meta, g_mix, w_in, 4608, 256, CKV, 256, 0, SSKV, lds, wave, lane);
        }
        }
    }
    SEAM(0);
    if (IN(1)) {
        PHASE_BEGIN();
        pg8::Gemm g{WSB(WS_XN), WSB(WS_WIN), MROWS, NIN, DM}; pg8::StaticOrder S; S.init(MROWS, NIN, G, bx);
        pg8::EpiInProj E{WSB(WS_RQ), WSB(WS_RK), WSB(WS_RV), WSB(WS_RG), WSB(WS_CQ), WSB(WS_CKV), WSB(WS_KRAW), ap->dummy ? WSU(WS_DUMMY) : WSU(WS_SSQ), ap->dummy ? WSU(WS_DUMMY + MiB) : WSU(WS_SSKV)};
        pg8::gemm_phase<pg8::EpiInProj, pg8::StaticOrder, true, true>(lds, g, S, E);
    }
    SEAM(1);
    if (IN(2)) {
        PHASE_BEGIN();
        const bf16* KRAW = WSB(WS_KRAW); bf16* KR2 = WSB(WS_KR2); const f32x2* ROPE = (const f32x2*)(ws + WS_ROPE);
        for (int i = gtid; i < MPAD * 32; i += ngt) {
            const int rp = i >> 5, t = i & 31, p = rp % LP; const int pos = p < 48 ? 0 : p - 48;
            const float x1 = bf2f(KRAW[(size_t)rp * 64 + t]), x2 = bf2f(KRAW[(size_t)rp * 64 + 32 + t]); const f32x2 cs = ROPE[pos * 64 + 2 * t];
            KR2[(size_t)rp * 64 + t] = (bf16)f2bf(x1 * cs.x - x2 * cs.y); KR2[(size_t)rp * 64 + 32 + t] = (bf16)f2bf(x1 * cs.y + x2 * cs.x);
        }
#if NAIVE_RET
        ret_naive(WSB(WS_RQ), WSB(WS_RK), WSB(WS_RV), WSB(WS_RG), ROPE, INP(4), WSB(WS_A2), gw, ngw, lane);
        const int GG = G, gc = bx; const bool do_gemm = true;
#else
        const int nret = G >= 256 ? 128 : G / 2;
        if (bx < nret && !(ap->dummy & 16)) { for (int it = bx; it < NB * 8; it += nret) ret_unit(lds, WSB(WS_RQ), WSB(WS_RK), WSB(WS_RV), WSB(WS_RG), ROPE, INP(4), WSB(WS_A2), it >> 3, it & 7, tid); }
        const int GG = G - nret, gc = bx - nret; const bool do_gemm = bx >= nret && !(ap->dummy & 32);
#endif
        if (do_gemm) {
            { pg8::Gemm g{WSB(WS_CQ), WSB(WS_WUQ), MROWS, 1536, 512}; pg8::StaticOrder S; S.init(MROWS, 1536, GG, gc);
              pg8::EpiRowScale E{WSB(WS_Q), 1536, WSU(WS_SSQ), 1.0f / (FIXS * 512.0f)};
              pg8::gemm_phase<pg8::EpiRowScale, pg8::StaticOrder, true, true>(lds, g, S, E); }
            { pg8::Gemm g{WSB(WS_CKV), WSB(WS_WUK), MPAD, 1024, 256}; pg8::StaticOrder S; S.init(MPAD, 1024, GG, gc);
              pg8::EpiRowScale E{WSB(WS_KN), 1024, WSU(WS_SSKV), 1.0f / (FIXS * 256.0f)};
              pg8::gemm_phase<pg8::EpiRowScale, pg8::StaticOrder, true, true>(lds, g, S, E); }
            { pg8::Gemm g{WSB(WS_WUV), WSB(WS_CKV), 1024, MPAD, 256}; pg8::StaticOrder S; S.init(1024, MPAD, GG, gc);
              pg8::EpiColScale E{WSB(WS_VT), MPAD, WSU(WS_SSKV), 1.0f / (FIXS * 256.0f)};
              pg8::gemm_phase<pg8::EpiColScale, pg8::StaticOrder, true, true>(lds, g, S, E); }
            { LAS float* scr = (LAS float*)(lds + wave * 16640); constexpr int J5 = 32 * 32, J6 = 32 * 128, J7 = 128 * 32;
              for (int it = gc * 8 + wave; it < J5 + J7 + J6 / 4; it += GG * 8) {
                  int r = it;
                  if (r >= J5 + J7) { r -= J5 + J7; p0_transpose_item(INP(13), 2048, 8192, 0, INP(12), 2048, 1.f, WSB(WS_WUP), scr, 24 + r / 128, r % 128, lane); continue; }
                  if (r < J5) { p0_transpose_item(INP(11), 2048, 2048, 1024, INP(10), 1024, 1.f, WSB(WS_WO), scr, r / 32, r % 32, lane); continue; } r -= J5;
                  p0_transpose_item(INP(14), 8192, 2048, 0, nullptr, 0, 1.f, WSB(WS_WDN), scr, r / 32, r % 32, lane);
              } }
        }
    }
    SEAM(2);
    if (IN(3)) {
        PHASE_BEGIN();
#if NAIVE_MLA
        mla_naive(WSB(WS_Q), WSB(WS_KN), WSB(WS_KR2), WSB(WS_VT), (const f32x2*)(ws + WS_ROPE), WSB(WS_A2), WSU(WS_SSMLA), gw, ngw, lane);
#else
        const int vcu = (G % 8 == 0) ? (bx % 8) * (G / 8) + bx / 8 : bx;
        for (int c = vcu; c < 256; c += G) {
            const int b = c >> 4, h = (c >> 1) & 7; const unsigned tbl = (c & 1) ? 0x1346u : 0x0257u;
#pragma unroll 1
            for (int j = 0; j < 4; ++j) mla_unit(lds, WSB(WS_Q), WSB(WS_KN), WSB(WS_KR2), WSB(WS_VT), (const f32x2*)(ws + WS_ROPE), WSB(WS_A2), ap->dummy ? WSU(WS_DUMMY) : WSU(WS_SSMLA), b, h, (int)((tbl >> (4 * j)) & 15u), tid);
        }
#endif
    }
    SEAM(3);
    if (IN(4)) {
        PHASE_BEGIN();
        pg8::Gemm g{WSB(WS_A2), WSB(WS_WO), MROWS, DM, DM}; pg8::StaticOrder S; S.init(MROWS, DM, G, bx);
        pg8::EpiWo E{INP(0), ap->out, WSB(WS_XN), ap->dummy ? WSU(WS_DUMMY) : WSU(WS_SSH1), WSU(WS_SSMLA)};
        pg8::gemm_phase<pg8::EpiWo, pg8::StaticOrder, true, true>(lds, g, S, E);
    }
    SEAM(4);
    if (IN(5)) {
        PHASE_BEGIN();
        pg8::Gemm g{WSB(WS_XN), WSB(WS_WUP), MROWS, FFN, DM}; pg8::StaticOrder S; S.init(MROWS, FFN, G, bx);
        pg8::EpiUp E{WSB(WS_HID), WSU(WS_SSH1)};
        pg8::gemm_phase<pg8::EpiUp, pg8::StaticOrder, true, true>(lds, g, S, E);
    }
    SEAM(5);
    if (IN(6)) {
        PHASE_BEGIN();
        const int vcu = (G % 8 == 0) ? (bx % 8) * (G / 8) + bx / 8 : bx;
        pg8::Gemm g{WSB(WS_HID), WSB(WS_WDN), MROWS, DM, FFN}; pg8::PanelOrder S{G, vcu};
        pg8::EpiDownNorm E{ap->out, WSB(WS_XN), INP(15), WSU(WS_SSFIN), (unsigned*)(ws + WS_CNT)};
        pg8::gemm_phase<pg8::EpiDownNorm, pg8::PanelOrder, true, true>(lds, g, S, E);
    }
#undef IN
#undef SEAM
}

extern "C" void kernel_launch(void* const* d_in, const int* in_sizes, int n_in, void* d_out, int out_size, void* d_ws, size_t ws_size, hipStream_t stream) {
    static int grid = 0;
    if (grid == 0) {
        if (n_in != 16 || in_sizes[0] != MROWS * DM || out_size != MROWS * DM || ws_size < 908 * MiB) { fprintf(stderr, "kernel_launch: unexpected problem geometry (n_in %d, ws %zu)\n", n_in, ws_size); grid = -1; return; }
        int dev = 0, cus = 0, per_cu = 0;
        (void)hipGetDevice(&dev); (void)hipDeviceGetAttribute(&cus, hipDeviceAttributeMultiprocessorCount, dev);
        if (hipFuncSetAttribute((const void*)hymba_fwd, hipFuncAttributeMaxDynamicSharedMemorySize, LDS_BYTES) != hipSuccess) { fprintf(stderr, "kernel_launch: hipFuncSetAttribute failed\n"); grid = -1; return; }
        if (hipOccupancyMaxActiveBlocksPerMultiprocessor(&per_cu, (const void*)hymba_fwd, 512, LDS_BYTES) != hipSuccess || per_cu < 1) per_cu = 1;
        (void)hipGetLastError();
        grid = cus * per_cu;
        if (grid <= 0) grid = 256;
    }
    if (grid < 0) return;
    Args a{};
    for (int i = 0; i < 16; ++i) a.in[i] = (const float*)d_in[i];
    a.out = (float*)d_out; a.ws = (unsigned char*)d_ws;
#if ONE_LAUNCH
    (void)hipMemsetAsync((unsigned char*)d_ws + WS_BAR, 0, XCD_BAR_WORDS * 4, stream);
    a.ph_lo = 0; a.ph_hi = NPHASE;
    void* kargs[] = {&a};
    hipError_t e = hipLaunchCooperativeKernel((const void*)hymba_fwd, dim3(grid), dim3(512), kargs, LDS_BYTES, stream);
    if (e != hipSuccess) fprintf(stderr, "cooperative launch failed: %s (grid %d)\n", hipGetErrorString(e), grid);
#else
    static const int seq[] = {PROBE_SEQ};
    for (unsigned i = 0; i < sizeof(seq) / sizeof(seq[0]); ++i) { a.ph_lo = seq[i] & 15; a.ph_hi = a.ph_lo + 1; a.dummy = seq[i] >> 4; hipLaunchKernelGGL(hymba_fwd, dim3(grid), dim3(512), LDS_BYTES, stream, a); }
#endif
}
```
